# Optimizing an MI355X kernel written in HIP

```python
import jax, jax.numpy as jnp
from jax import lax
import numpy as np

D_MODEL = 1024
BATCH = 32
SEQ = 2048
DEPTH = 1

CONV_WIDTH = D_MODEL
CONV_K = 3
N_Q_HEADS = 16
N_KV_HEADS = 2
HEAD_DIM = 64
ATTN_WIDTH = N_Q_HEADS * HEAD_DIM
KV_WIDTH = N_KV_HEADS * HEAD_DIM
GROUP = N_Q_HEADS // N_KV_HEADS
WINDOW = 128
BLOCK = 128
PROJ_WIDTH = 3 * CONV_WIDTH + ATTN_WIDTH + 2 * KV_WIDTH
D_FF = 2816
FFN_RESIDUAL = 0.5
N_BRANCHES = 2
EPS = 1e-6
NEG_INF = -1e30

kernel_name = "hybrid_shortconv_swa_sink_macaron_block"


def rms_norm(x, w):
    xf = x.astype(jnp.float32)
    y = xf * lax.rsqrt(jnp.mean(xf * xf, axis=-1, keepdims=True) + EPS)
    return (y * w.astype(jnp.float32)).astype(x.dtype)


def swiglu(x, w_gate, w_up, w_down):
    return (jax.nn.silu(x @ w_gate) * (x @ w_up)) @ w_down


def causal_depthwise_conv(z, w):
    S = z.shape[1]
    zp = jnp.pad(z, ((0, 0), (CONV_K - 1, 0), (0, 0)))
    y = zp[:, 0:S] * w[0]
    for k in range(1, CONV_K):
        y = y + zp[:, k:k + S] * w[k]
    return y


def sliding_window_attention(q, k, v, sinks):
    B, S = q.shape[0], q.shape[1]
    nb = S // BLOCK
    qb = q.reshape(B, nb, BLOCK, N_KV_HEADS, GROUP, HEAD_DIM)
    pad = jnp.zeros((B, BLOCK, N_KV_HEADS, HEAD_DIM), k.dtype)
    kp = jnp.concatenate([pad, k], axis=1).reshape(B, nb + 1, BLOCK, N_KV_HEADS, HEAD_DIM)
    vp = jnp.concatenate([pad, v], axis=1).reshape(B, nb + 1, BLOCK, N_KV_HEADS, HEAD_DIM)
    kb = jnp.concatenate([kp[:, :-1], kp[:, 1:]], axis=2)
    vb = jnp.concatenate([vp[:, :-1], vp[:, 1:]], axis=2)
    scale = HEAD_DIM ** -0.5
    scores = jnp.einsum('bnqhgd,bnkhd->bnhgqk', qb, kb).astype(jnp.float32) * scale
    qpos = jnp.arange(BLOCK)[:, None] + BLOCK
    kpos = jnp.arange(2 * BLOCK)[None, :]
    band = (kpos <= qpos) & (qpos - kpos < WINDOW)
    not_pad = (jnp.arange(nb)[:, None, None] > 0) | (kpos[None] >= BLOCK)
    mask = band[None] & not_pad
    scores = jnp.where(mask[None, :, None, None], scores, NEG_INF)
    sink = sinks.astype(jnp.float32).reshape(N_KV_HEADS, GROUP)[None, None, :, :, None, None]
    sink = jnp.broadcast_to(sink, scores.shape[:-1] + (1,))
    probs = jax.nn.softmax(jnp.concatenate([scores, sink], axis=-1), axis=-1)[..., :-1]
    out = jnp.einsum('bnhgqk,bnkhd->bnqhgd', probs.astype(v.dtype), vb)
    return out.reshape(B, S, ATTN_WIDTH)


def setup_inputs(seed: int = 0) -> dict:
    key = jax.random.key(seed)
    ks = jax.random.split(key, 24)
    L, D = DEPTH, D_MODEL

    def w(k, shape, fan_in):
        return jax.random.normal(k, shape, jnp.float32) * fan_in ** -0.5

    def gain(k, shape):
        return 1.0 + 0.05 * jax.random.normal(k, shape, jnp.float32)

    return {
        "x": jax.random.normal(ks[0], (BATCH, SEQ, D), jnp.float32),
        "ffn1_norm": gain(ks[1], (L, D)),
        "ffn1_w_gate": w(ks[2], (L, D, D_FF), D),
        "ffn1_w_up": w(ks[3], (L, D, D_FF), D),
        "ffn1_w_down": w(ks[4], (L, D_FF, D), D_FF),
        "mix_norm": gain(ks[5], (L, D)),
        "w_in": w(ks[6], (L, D, PROJ_WIDTH), D),
        "conv_w": w(ks[7], (L, CONV_K, CONV_WIDTH), CONV_K),
        "q_norm": gain(ks[8], (L, HEAD_DIM)),
        "k_norm": gain(ks[9], (L, HEAD_DIM)),
        "sinks": 0.5 * jax.random.normal(ks[10], (L, N_Q_HEADS), jnp.float32),
        "w_conv_out": w(ks[11], (L, CONV_WIDTH, D), CONV_WIDTH),
        "w_attn_out": w(ks[12], (L, ATTN_WIDTH, D), ATTN_WIDTH),
        "w_branch_gate": w(ks[13], (L, D, N_BRANCHES * D), D),
        "b_branch_gate": 0.02 * jax.random.normal(ks[14], (L, N_BRANCHES * D), jnp.float32),
        "w_out": w(ks[15], (L, D, D), D),
        "ffn2_norm": gain(ks[16], (L, D)),
        "ffn2_w_gate": w(ks[17], (L, D, D_FF), D),
        "ffn2_w_up": w(ks[18], (L, D, D_FF), D),
        "ffn2_w_down": w(ks[19], (L, D_FF, D), D_FF),
    }


def reference(x, ffn1_norm, ffn1_w_gate, ffn1_w_up, ffn1_w_down, mix_norm, w_in, conv_w,
              q_norm, k_norm, sinks, w_conv_out, w_attn_out, w_branch_gate, b_branch_gate,
              w_out, ffn2_norm, ffn2_w_gate, ffn2_w_up, ffn2_w_down):
    B, S = x.shape[0], x.shape[1]
    for l in range(DEPTH):
        x = x + FFN_RESIDUAL * swiglu(rms_norm(x, ffn1_norm[l]), ffn1_w_gate[l], ffn1_w_up[l], ffn1_w_down[l])

        h = rms_norm(x, mix_norm[l])
        p = h @ w_in[l]
        c0 = 3 * CONV_WIDTH
        gb, gc, vc = jnp.split(p[..., :c0], 3, axis=-1)
        q = p[..., c0:c0 + ATTN_WIDTH].reshape(B, S, N_Q_HEADS, HEAD_DIM)
        k = p[..., c0 + ATTN_WIDTH:c0 + ATTN_WIDTH + KV_WIDTH].reshape(B, S, N_KV_HEADS, HEAD_DIM)
        v = p[..., c0 + ATTN_WIDTH + KV_WIDTH:].reshape(B, S, N_KV_HEADS, HEAD_DIM)

        y_conv = (gb * causal_depthwise_conv(gc * vc, conv_w[l])) @ w_conv_out[l]

        q = rms_norm(q, q_norm[l])
        k = rms_norm(k, k_norm[l])
        y_attn = sliding_window_attention(q, k, v, sinks[l]) @ w_attn_out[l]

        g = jax.nn.sigmoid(h @ w_branch_gate[l] + b_branch_gate[l]).reshape(B, S, N_BRANCHES, D_MODEL)
        merged = g[:, :, 0] * y_conv + g[:, :, 1] * y_attn
        x = x + merged @ w_out[l]

        x = x + FFN_RESIDUAL * swiglu(rms_norm(x, ffn2_norm[l]), ffn2_w_gate[l], ffn2_w_up[l], ffn2_w_down[l])
    return x
```

```cpp
#include <hip/hip_runtime.h>
#include <hip/hip_cooperative_groups.h>
#include <cstdio>
#include <cstdint>
namespace cg = cooperative_groups;

#ifndef MK_N_LAUNCHES
#define MK_N_LAUNCHES 1
#endif

#define LAS __attribute__((address_space(3)))
typedef unsigned short bf16_t;
typedef short bf16x8 __attribute__((ext_vector_type(8)));
typedef float f32x4 __attribute__((ext_vector_type(4)));
typedef float f32x16 __attribute__((ext_vector_type(16)));
typedef unsigned u32x4 __attribute__((ext_vector_type(4)));
typedef unsigned u32x2 __attribute__((ext_vector_type(2)));
typedef float f32x2_t __attribute__((ext_vector_type(2)));
typedef __bf16 bf16x2_t __attribute__((ext_vector_type(2)));

constexpr int M = 65536, D = 1024, FF = 2816, SEQ = 2048;
constexpr int NP = 6400;
constexpr int PC_C = 0, PC_VC = 1024, PC_B = 2048, PC_Q = 3072, PC_K = 4096, PC_V = 4224, PC_GC = 4352, PC_GA = 5376;
constexpr float EPS = 1e-6f;
constexpr float LOG2E = 1.4426950408889634f;

constexpr size_t MiB = 1u << 20;
constexpr size_t WS_W1 = 0;
constexpr size_t WS_W2 = 11 * MiB;
constexpr size_t WS_W3 = 17 * MiB;
constexpr size_t WS_W4 = 30 * MiB;
constexpr size_t WS_W5 = 34 * MiB;
constexpr size_t WS_W6 = 36 * MiB;
constexpr size_t WS_W7 = 47 * MiB;
constexpr size_t WS_PART1 = 53 * MiB;
constexpr size_t WS_PART2 = 57 * MiB;
constexpr size_t WS_XN = 64 * MiB;
constexpr size_t WS_P = 192 * MiB;
constexpr size_t WS_X2G = WS_P;
constexpr size_t WS_H = WS_P + 128 * MiB;
constexpr size_t WS_END = WS_P + 800 * MiB;

constexpr int RING_BYTES = 131072;
constexpr int LDS_BYTES = 147456;

__device__ __forceinline__ unsigned cvtpk(float lo, float hi) { f32x2_t v = {lo, hi}; bf16x2_t b = __builtin_convertvector(v, bf16x2_t); return __builtin_bit_cast(unsigned, b); }
__device__ __forceinline__ float bflo(unsigned w) { return __uint_as_float(w << 16); }
__device__ __forceinline__ float bfhi(unsigned w) { return __uint_as_float(w & 0xffff0000u); }
__device__ __forceinline__ float sigmoidf_(float z) { return __builtin_amdgcn_rcpf(1.f + __expf(-z)); }
__device__ __forceinline__ float rstd_from_parts(const float* p) {
    const f32x4 a = ((const f32x4*)p)[0], b = ((const f32x4*)p)[1], c = ((const f32x4*)p)[2], d = ((const f32x4*)p)[3];
    const float s = (((a.x + a.y) + (a.z + a.w)) + ((b.x + b.y) + (b.z + b.w))) + (((c.x + c.y) + (c.z + c.w)) + ((d.x + d.y) + (d.z + d.w)));
    return rsqrtf(s * (1.0f / 1024.0f) + EPS);
}

namespace pg8 {
constexpr int BM = 256, BK = 64, HALF = 128, HTB = HALF * BK * 2, STAGE_BYTES = 8 * HTB, NXCD = 8, WGM = 8;
__host__ __device__ __forceinline__ int lds_byte(int r, int c) { const int st = (r >> 4) * 2 + (c >> 5), rr = r & 15, cc = c & 31, ob = rr * 64 + cc * 2; return st * 1024 + (ob ^ (((ob >> 9) & 1) << 5)); }
__host__ __device__ __forceinline__ void stage_rc(int b, int& R, int& C) { const int st = b / 1024, sb = b % 1024, swz = sb ^ (((sb >> 9) & 1) << 5); R = (st >> 1) * 16 + swz / 64; C = (st & 1) * 32 + (swz % 64) / 2; }
__host__ __device__ __forceinline__ int perm32(int rho) { const int n = rho >> 4, i = rho & 15; return 8 * (i >> 2) + 4 * n + (i & 3); }

struct Unit { int pm, pn; };
struct Gemm { const bf16_t* A; const bf16_t* Bt; int lda, N, K; };

struct StaticOrder {
    int nM, nN, nwg, G, c;
    __device__ void init(int Mr, int N, int G_, int c_) { nM = Mr / BM; nN = N / BM; nwg = nM * nN; G = G_; c = c_; }
    __device__ bool next(int i, Unit& u) const {
        const long L = (long)i * G + c; if (L >= nwg) return false;
        int wgid = (int)L; { const int q = nwg / NXCD, r = nwg % NXCD, xcd = wgid % NXCD, off = wgid / NXCD; wgid = (xcd < r ? xcd * (q + 1) : r * (q + 1) + (xcd - r) * q) + off; }
        const int nig = WGM * nN, gid = wgid / nig, fm = gid * WGM, gsz = (nM - fm) < WGM ? (nM - fm) : WGM;
        u.pm = fm + ((wgid % nig) % gsz); u.pn = (wgid % nig) / gsz; return true;
    }
};

typedef f32x4 Acc[2][2][4][2];

struct EpiSwiglu {
    static constexpr bool HAS_MID = false; static constexpr int MID_T = -1;
    bf16_t* H; const float* part;
    __device__ __forceinline__ void mid(Acc&, const Unit&, int, int, int, int) const {}
    __device__ __forceinline__ void operator()(const Acc& acc, const Unit& u, int wr, int wc, int fr, int fq) const {
        const int row0 = u.pm * BM + wr * 64 + fr, col0 = u.pn * HALF + wc * 32 + 8 * fq;
#pragma unroll
        for (int ai = 0; ai < 2; ++ai)
#pragma unroll
            for (int m = 0; m < 4; ++m) {
                const int row = row0 + ai * HALF + m * 16;
                const float rs = part ? rstd_from_parts(part + (size_t)row * 16) : 1.0f;
                float h[8];
#pragma unroll
                for (int n = 0; n < 2; ++n)
#pragma unroll
                    for (int i = 0; i < 4; ++i) { const float g = acc[ai][0][m][n][i] * rs, up = acc[ai][1][m][n][i] * rs; h[4 * n + i] = g * sigmoidf_(g) * up; }
                u32x4 w; w.x = cvtpk(h[0], h[1]); w.y = cvtpk(h[2], h[3]); w.z = cvtpk(h[4], h[5]); w.w = cvtpk(h[6], h[7]);
                *(u32x4*)(H + (size_t)row * FF + col0) = w;
            }
    }
};

struct EpiResid {
    static constexpr bool HAS_MID = false; static constexpr int MID_T = -1;
    const float* base; float* out; float alpha; bf16_t* xg; const float* gnext; float* part;
    __device__ __forceinline__ void mid(Acc&, const Unit&, int, int, int, int) const {}
    __device__ __forceinline__ void operator()(const Acc& acc, const Unit& u, int wr, int wc, int fr, int fq) const {
        const int row0 = u.pm * BM + wr * 64 + fr, col0 = u.pn * BM + wc * 32 + 8 * fq;
        f32x4 gv[2][2];
#pragma unroll
        for (int bj = 0; bj < 2; ++bj)
#pragma unroll
            for (int n = 0; n < 2; ++n) gv[bj][n] = xg ? *(const f32x4*)(gnext + col0 + bj * HALF + 4 * n) : (f32x4){0.f, 0.f, 0.f, 0.f};
#pragma unroll
        for (int ai = 0; ai < 2; ++ai)
#pragma unroll
            for (int m = 0; m < 4; ++m) {
                const int row = row0 + ai * HALF + m * 16; float ss = 0.f;
#pragma unroll
                for (int bj = 0; bj < 2; ++bj) {
                    const size_t off = (size_t)row * D + col0 + bj * HALF;
                    const f32x4 b0 = *(const f32x4*)(base + off), b1 = *(const f32x4*)(base + off + 4);
                    const f32x4 v0 = b0 + acc[ai][bj][m][0] * alpha, v1 = b1 + acc[ai][bj][m][1] * alpha;
                    *(f32x4*)(out + off) = v0; *(f32x4*)(out + off + 4) = v1;
                    ss += (v0.x * v0.x + v0.y * v0.y) + (v0.z * v0.z + v0.w * v0.w) + (v1.x * v1.x + v1.y * v1.y) + (v1.z * v1.z + v1.w * v1.w);
                    if (xg) { const f32x4 a = v0 * gv[bj][0], b = v1 * gv[bj][1]; u32x4 w; w.x = cvtpk(a.x, a.y); w.y = cvtpk(a.z, a.w); w.z = cvtpk(b.x, b.y); w.w = cvtpk(b.z, b.w); *(u32x4*)(xg + off) = w; }
                }
                if (part) { ss += __shfl_xor(ss, 16); ss += __shfl_xor(ss, 32); if (fq == 0) part[(size_t)row * 16 + u.pn * 4 + wc] = ss; }
            }
    }
};

struct EpiProj {
    static constexpr bool HAS_MID = false; static constexpr int MID_T = -1;
    bf16_t* P; const float* part; const float* bias;
    __device__ __forceinline__ void mid(Acc&, const Unit&, int, int, int, int) const {}
    __device__ __forceinline__ void operator()(const Acc& acc, const Unit& u, int wr, int wc, int fr, int fq) const {
        const int row0 = u.pm * BM + wr * 64 + fr, col0 = u.pn * BM + wc * 32 + 8 * fq; const bool gate = u.pn >= 17;
        f32x4 bv[2][2];
#pragma unroll
        for (int bj = 0; bj < 2; ++bj)
#pragma unroll
            for (int n = 0; n < 2; ++n) bv[bj][n] = gate ? *(const f32x4*)(bias + (col0 - PC_GC) + bj * HALF + 4 * n) : (f32x4){0.f, 0.f, 0.f, 0.f};
#pragma unroll
        for (int ai = 0; ai < 2; ++ai)
#pragma unroll
            for (int m = 0; m < 4; ++m) {
                const int row = row0 + ai * HALF + m * 16; const float rs = rstd_from_parts(part + (size_t)row * 16);
#pragma unroll
                for (int bj = 0; bj < 2; ++bj) {
                    f32x4 v0 = acc[ai][bj][m][0] * rs + bv[bj][0], v1 = acc[ai][bj][m][1] * rs + bv[bj][1];
                    if (gate) { v0.x = sigmoidf_(v0.x); v0.y = sigmoidf_(v0.y); v0.z = sigmoidf_(v0.z); v0.w = sigmoidf_(v0.w); v1.x = sigmoidf_(v1.x); v1.y = sigmoidf_(v1.y); v1.z = sigmoidf_(v1.z); v1.w = sigmoidf_(v1.w); }
                    u32x4 w; w.x = cvtpk(v0.x, v0.y); w.y = cvtpk(v0.z, v0.w); w.z = cvtpk(v1.x, v1.y); w.w = cvtpk(v1.z, v1.w);
                    *(u32x4*)(P + (size_t)row * NP + col0 + bj * HALF) = w;
                }
            }
    }
};

struct EpiMix {
    static constexpr bool HAS_MID = true; static constexpr int MID_T = 16;
    const bf16_t* P; bf16_t* out;
    __device__ __forceinline__ void mid(Acc& acc, const Unit& u, int wr, int wc, int fr, int fq) const {
        int row0 = u.pm * BM + wr * 64 + fr; const int col0 = u.pn * BM + wc * 32 + 8 * fq;
        asm volatile("" : "+v"(row0));
#pragma unroll
        for (int ai = 0; ai < 2; ++ai)
#pragma unroll
            for (int m = 0; m < 4; ++m) {
                const int row = row0 + ai * HALF + m * 16;
#pragma unroll
                for (int bj = 0; bj < 2; ++bj) {
                    const bf16_t* pr = P + (size_t)row * NP + col0 + bj * HALF;
                    const u32x4 gc = *(const u32x4*)(pr + PC_GC), ga = *(const u32x4*)(pr + PC_GA);
                    f32x4 r0, r1;
                    r0.x = bflo(gc.x) * __builtin_amdgcn_rcpf(fmaxf(bflo(ga.x), 1e-30f)); r0.y = bfhi(gc.x) * __builtin_amdgcn_rcpf(fmaxf(bfhi(ga.x), 1e-30f));
                    r0.z = bflo(gc.y) * __builtin_amdgcn_rcpf(fmaxf(bflo(ga.y), 1e-30f)); r0.w = bfhi(gc.y) * __builtin_amdgcn_rcpf(fmaxf(bfhi(ga.y), 1e-30f));
                    r1.x = bflo(gc.z) * __builtin_amdgcn_rcpf(fmaxf(bflo(ga.z), 1e-30f)); r1.y = bfhi(gc.z) * __builtin_amdgcn_rcpf(fmaxf(bfhi(ga.z), 1e-30f));
                    r1.z = bflo(gc.w) * __builtin_amdgcn_rcpf(fmaxf(bflo(ga.w), 1e-30f)); r1.w = bfhi(gc.w) * __builtin_amdgcn_rcpf(fmaxf(bfhi(ga.w), 1e-30f));
                    acc[ai][bj][m][0] *= r0; acc[ai][bj][m][1] *= r1;
                }
                if (m & 1) asm volatile("" ::: "memory");
            }
    }
    __device__ __forceinline__ void operator()(const Acc& acc, const Unit& u, int wr, int wc, int fr, int fq) const {
        const int row0 = u.pm * BM + wr * 64 + fr, col0 = u.pn * BM + wc * 32 + 8 * fq;
#pragma unroll
        for (int ai = 0; ai < 2; ++ai)
#pragma unroll
            for (int m = 0; m < 4; ++m) {
                const int row = row0 + ai * HALF + m * 16;
#pragma unroll
                for (int bj = 0; bj < 2; ++bj) {
                    const u32x4 ga = *(const u32x4*)(P + (size_t)row * NP + col0 + bj * HALF + PC_GA);
                    f32x4 g0, g1;
                    g0.x = fmaxf(bflo(ga.x), 1e-30f); g0.y = fmaxf(bfhi(ga.x), 1e-30f); g0.z = fmaxf(bflo(ga.y), 1e-30f); g0.w = fmaxf(bfhi(ga.y), 1e-30f);
                    g1.x = fmaxf(bflo(ga.z), 1e-30f); g1.y = fmaxf(bfhi(ga.z), 1e-30f); g1.z = fmaxf(bflo(ga.w), 1e-30f); g1.w = fmaxf(bfhi(ga.w), 1e-30f);
                    const f32x4 v0 = acc[ai][bj][m][0] * g0, v1 = acc[ai][bj][m][1] * g1;
                    u32x4 w; w.x = cvtpk(v0.x, v0.y); w.y = cvtpk(v0.z, v0.w); w.z = cvtpk(v1.x, v1.y); w.w = cvtpk(v1.z, v1.w);
                    *(u32x4*)(out + (size_t)row * D + col0 + bj * HALF) = w;
                }
            }
    }
};

template <class Epi>
__device__ __forceinline__ void gemm_phase(LAS unsigned char* lds, const Gemm g, const StaticOrder& S, const Epi& E) {
    const int tid = threadIdx.x, wid = __builtin_amdgcn_readfirstlane(tid >> 6), lane = tid & 63, wr = wid >> 2, wc = wid & 3, fr = lane & 15, fq = lane >> 4;
    const int K = g.K, nt = K / BK, lda = g.lda;
    unsigned voffA[2], voffB[2];
#pragma unroll
    for (int i = 0; i < 2; ++i) { int R, C; stage_rc(tid * 16 + i * 8192, R, C); const int Rb = (R & ~31) + perm32(R & 31);
        voffA[i] = (unsigned)(R * lda + C) * 2u; voffB[i] = (unsigned)(Rb * K + C) * 2u; }
    const size_t kstep = (size_t)(BK * 2);
    const size_t hstepA = (size_t)HALF * lda * 2, hstepB = (size_t)HALF * K * 2;
    const size_t tstepA = 2 * hstepA, tstepB = 2 * hstepB;
    const unsigned ldsw = (unsigned)wid * 1024u;
    const int aoff = lds_byte(wr * 64 + fr, fq * 8), boff = lds_byte(wc * 32 + fr, fq * 8);
#define PG8_SA(b, h) (((b) * 2 + (h)) * HTB)
#define PG8_SB(b, h) ((4 + (b) * 2 + (h)) * HTB)
#define PG8_STAGE(bufoff, gbase, voff) do { _Pragma("unroll") for (int _i = 0; _i < 2; ++_i) \
        __builtin_amdgcn_global_load_lds((const unsigned*)((const char*)(gbase) + (voff)[_i]), (LAS unsigned*)(lds + (bufoff) + ldsw + _i * 8192), 16, 0, 0); } while (0)
#define PG8_LDA(dst, b, h) do { _Pragma("unroll") for (int m = 0; m < 4; ++m) _Pragma("unroll") for (int k = 0; k < 2; ++k) dst[m][k] = *(const LAS bf16x8*)(lds + PG8_SA(b, h) + aoff + m * 2048 + k * 1024); } while (0)
#define PG8_LDB(dst, b, h) do { _Pragma("unroll") for (int n = 0; n < 2; ++n) _Pragma("unroll") for (int k = 0; k < 2; ++k) dst[n][k] = *(const LAS bf16x8*)(lds + PG8_SB(b, h) + boff + n * 2048 + k * 1024); } while (0)
#define PG8_MMA(ai, bj, At, Bt) do { __builtin_amdgcn_s_setprio(1); _Pragma("unroll") for (int m = 0; m < 4; ++m) _Pragma("unroll") for (int n = 0; n < 2; ++n) _Pragma("unroll") for (int k = 0; k < 2; ++k) \
        acc[ai][bj][m][n] = __builtin_amdgcn_mfma_f32_16x16x32_bf16(Bt[n][k], At[m][k], acc[ai][bj][m][n], 0, 0, 0); __builtin_amdgcn_s_setprio(0); } while (0)
#define PG8_WAIT_V(n) asm volatile("s_waitcnt vmcnt(" #n ")" ::: "memory")
#define PG8_WAIT_L(n) asm volatile("s_waitcnt lgkmcnt(" #n ")" ::: "memory")
#define PG8_BAR __builtin_amdgcn_s_barrier()
#define PG8_SCHED __builtin_amdgcn_sched_barrier(0)
    Unit cur, nxt; int ui = 0;
    if (!S.next(0, cur)) return;
    Acc acc;
#pragma unroll
    for (int a = 0; a < 2; ++a)
#pragma unroll
        for (int b = 0; b < 2; ++b)
#pragma unroll
            for (int m = 0; m < 4; ++m)
#pragma unroll
                for (int n = 0; n < 2; ++n) acc[a][b][m][n] = (f32x4){0.f, 0.f, 0.f, 0.f};
    bf16x8 At[4][2], B0[2][2], B1[2][2];
    const char* cA = (const char*)g.A + (size_t)cur.pm * tstepA; const char* cB = (const char*)g.Bt + (size_t)cur.pn * tstepB;
    PG8_STAGE(PG8_SB(0, 0), cB, voffB); PG8_STAGE(PG8_SB(0, 1), cB + hstepB, voffB); PG8_STAGE(PG8_SA(0, 0), cA, voffA); PG8_STAGE(PG8_SA(0, 1), cA + hstepA, voffA);
    if (wr == 1) PG8_BAR;
    PG8_WAIT_V(2); PG8_BAR;
    PG8_STAGE(PG8_SB(1, 0), cB + kstep, voffB); PG8_STAGE(PG8_SA(1, 0), cA + kstep, voffA); PG8_STAGE(PG8_SB(1, 1), cB + hstepB + kstep, voffB);
    PG8_WAIT_V(6); PG8_BAR;
    for (;;) {
        const bool has_next = S.next(ui + 1, nxt);
        const char* nA = has_next ? (const char*)g.A + (size_t)nxt.pm * tstepA : cA; const char* nB = has_next ? (const char*)g.Bt + (size_t)nxt.pn * tstepB : cB;
        for (int t = 0; t < nt; t += 2) {
            if constexpr (Epi::HAS_MID) { if (t == Epi::MID_T) { E.mid(acc, cur, wr, wc, fr, fq); PG8_SCHED; } }
            const bool last = (t == nt - 2);
            const char* a1 = cA + (size_t)(t + 1) * kstep;
            const char* a2 = last ? nA : cA + (size_t)(t + 2) * kstep; const char* b2 = last ? nB : cB + (size_t)(t + 2) * kstep;
            const char* a3 = a2 + kstep; const char* b3 = b2 + kstep;
            PG8_LDB(B0, 0, 0); PG8_LDB(B1, 0, 1); PG8_SCHED; PG8_LDA(At, 0, 0); PG8_STAGE(PG8_SA(1, 1), a1 + hstepA, voffA);
            PG8_WAIT_V(8); PG8_WAIT_L(0); PG8_BAR; PG8_MMA(0, 0, At, B0); PG8_MMA(0, 1, At, B1); PG8_BAR; PG8_SCHED;
            PG8_LDA(At, 0, 1); PG8_STAGE(PG8_SB(0, 0), b2, voffB); PG8_STAGE(PG8_SB(0, 1), b2 + hstepB, voffB); PG8_STAGE(PG8_SA(0, 0), a2, voffA);
            PG8_WAIT_V(8); PG8_WAIT_L(0); PG8_BAR; PG8_MMA(1, 0, At, B0); PG8_MMA(1, 1, At, B1); PG8_BAR; PG8_SCHED;
            PG8_LDB(B0, 1, 0); PG8_LDB(B1, 1, 1); PG8_SCHED; PG8_LDA(At, 1, 0); PG8_STAGE(PG8_SA(0, 1), a2 + hstepA, voffA);
            PG8_WAIT_V(8); PG8_WAIT_L(0); PG8_BAR; PG8_MMA(0, 0, At, B0); PG8_MMA(0, 1, At, B1); PG8_BAR; PG8_SCHED;
            PG8_LDA(At, 1, 1); PG8_STAGE(PG8_SB(1, 0), b3, voffB); PG8_STAGE(PG8_SB(1, 1), b3 + hstepB, voffB); PG8_STAGE(PG8_SA(1, 0), a3, voffA);
            PG8_WAIT_V(8); PG8_WAIT_L(0); PG8_BAR; PG8_MMA(1, 0, At, B0); PG8_MMA(1, 1, At, B1); PG8_BAR; PG8_SCHED;
        }
        if (wr == 0) PG8_BAR;
        E(acc, cur, wr, wc, fr, fq);
        if (!has_next) break;
#pragma unroll
        for (int a = 0; a < 2; ++a)
#pragma unroll
            for (int b = 0; b < 2; ++b)
#pragma unroll
                for (int m = 0; m < 4; ++m)
#pragma unroll
                    for (int n = 0; n < 2; ++n) acc[a][b][m][n] = (f32x4){0.f, 0.f, 0.f, 0.f};
        cur = nxt; cA = nA; cB = nB; ++ui;
        if (wr == 1) PG8_BAR;
    }
    PG8_WAIT_V(0);
    PG8_BAR;
#undef PG8_SA
#undef PG8_SB
#undef PG8_STAGE
#undef PG8_LDA
#undef PG8_LDB
#undef PG8_MMA
#undef PG8_WAIT_V
#undef PG8_WAIT_L
#undef PG8_BAR
#undef PG8_SCHED
}
}

__device__ __forceinline__ float wave_sum(float v) {
#pragma unroll
    for (int o = 1; o < 64; o <<= 1) v += __shfl_xor(v, o);
    return v;
}
__device__ __forceinline__ void p0_transpose_item(const float* W, int N, bf16_t* WT, int ldk, int koff, int drow0, int k0, int n0, LAS float* scr, int lane) {
#pragma unroll 8
    for (int i = 0; i < 32; ++i) { const int kk = 2 * i + (lane >> 5); scr[kk * 33 + (lane & 31)] = W[(size_t)(k0 + kk) * N + n0 + (lane & 31)]; }
    asm volatile("s_waitcnt lgkmcnt(0)" ::: "memory");
    const int c = lane & 7;
#pragma unroll
    for (int j = 0; j < 4; ++j) { const int n = (lane >> 3) + 8 * j; const LAS float* s = scr + (8 * c) * 33 + n;
        u32x4 o; o.x = cvtpk(s[0 * 33], s[1 * 33]); o.y = cvtpk(s[2 * 33], s[3 * 33]); o.z = cvtpk(s[4 * 33], s[5 * 33]); o.w = cvtpk(s[6 * 33], s[7 * 33]);
        *(u32x4*)(WT + (size_t)(drow0 + n) * ldk + koff + k0 + 8 * c) = o; }
    asm volatile("s_waitcnt lgkmcnt(0)" ::: "memory");
}

namespace att {
constexpr int KPB = 144;
constexpr int VP = 260;
constexpr int LDS_K = 0, LDS_V = 36864, LDS_WS = 70144, LDS_OST = 72192, LDS_END = 104960;
__device__ __forceinline__ int crow(int r, int hi) { return (r & 3) + 8 * (r >> 2) + 4 * hi; }

__device__ __forceinline__ void attn_unit(LAS unsigned char* lds, bf16_t* P, const float* qn_w, const float* kn_w, const float* sinks, int unit, int tid, int wid, int lane) {
    const int hk = unit & 1, n = (unit >> 1) & 15, b = unit >> 5;
    const int T0 = n * 128; const size_t rowbase = (size_t)b * SEQ;
    {
        const int kk = tid >> 1, half = tid & 1; const int kp = T0 - 128 + kk;
        u32x4 kr[4], vr[4];
        if (kp >= 0) { const bf16_t* pr = P + (rowbase + kp) * NP + PC_K + hk * 64 + half * 32;
#pragma unroll
            for (int i = 0; i < 4; ++i) { kr[i] = *(const u32x4*)(pr + 8 * i); vr[i] = *(const u32x4*)(pr + 128 + 8 * i); } }
        else {
#pragma unroll
            for (int i = 0; i < 4; ++i) { kr[i] = (u32x4){0u, 0u, 0u, 0u}; vr[i] = (u32x4){0u, 0u, 0u, 0u}; } }
        float ss = 0.f;
#pragma unroll
        for (int i = 0; i < 4; ++i)
#pragma unroll
            for (int e = 0; e < 4; ++e) { const float a = bflo(kr[i][e]), c = bfhi(kr[i][e]); ss += a * a + c * c; }
        ss += __shfl_xor(ss, 1);
        const float rs = rsqrtf(ss * (1.0f / 64.0f) + EPS);
#pragma unroll
        for (int i = 0; i < 4; ++i) {
            const f32x4 w0 = *(const f32x4*)(kn_w + half * 32 + 8 * i), w1 = *(const f32x4*)(kn_w + half * 32 + 8 * i + 4);
            u32x4 o;
            o.x = cvtpk(bflo(kr[i].x) * rs * w0.x, bfhi(kr[i].x) * rs * w0.y); o.y = cvtpk(bflo(kr[i].y) * rs * w0.z, bfhi(kr[i].y) * rs * w0.w);
            o.z = cvtpk(bflo(kr[i].z) * rs * w1.x, bfhi(kr[i].z) * rs * w1.y); o.w = cvtpk(bflo(kr[i].w) * rs * w1.z, bfhi(kr[i].w) * rs * w1.w);
            *(LAS u32x4*)(lds + LDS_K + kk * KPB + half * 64 + 16 * i) = o;
        }
#pragma unroll
        for (int i = 0; i < 4; ++i)
#pragma unroll
            for (int e = 0; e < 8; ++e) {
                const unsigned short val = (unsigned short)((vr[i][e >> 1] >> (16 * (e & 1))) & 0xffffu);
                *(LAS unsigned short*)(lds + LDS_V + ((half * 32 + 8 * i + e) * VP + kk) * 2) = val;
            }
    }
    __syncthreads();
    const int h = hk * 8 + wid, r32 = lane & 31, hi = lane >> 5;
    const float sink2 = sinks[h] * LOG2E;
    LAS float* wsf = (LAS float*)(lds + LDS_WS) + wid * 64;
    LAS bf16_t* stg = (LAS bf16_t*)(lds + LDS_OST) + wid * 2048;
    const float NEG = -1e30f;
#pragma unroll 1
    for (int j = 0; j < 4; ++j) {
        bf16_t* qp = P + (rowbase + T0 + 32 * j + r32) * NP + PC_Q + h * 64;
        u32x4 qraw[4]; float ss = 0.f;
#pragma unroll
        for (int d0 = 0; d0 < 4; ++d0) { qraw[d0] = *(const u32x4*)(qp + 16 * d0 + 8 * hi);
#pragma unroll
            for (int e = 0; e < 4; ++e) { const float a = bflo(qraw[d0][e]), c = bfhi(qraw[d0][e]); ss += a * a + c * c; } }
        ss += __shfl_xor(ss, 32);
        const float rs = rsqrtf(ss * (1.0f / 64.0f) + EPS) * (0.125f * LOG2E);
        bf16x8 qr[4];
#pragma unroll
        for (int d0 = 0; d0 < 4; ++d0) {
            const f32x4 w0 = *(const f32x4*)(qn_w + 16 * d0 + 8 * hi), w1 = *(const f32x4*)(qn_w + 16 * d0 + 8 * hi + 4);
            u32x4 o;
            o.x = cvtpk(bflo(qraw[d0].x) * rs * w0.x, bfhi(qraw[d0].x) * rs * w0.y); o.y = cvtpk(bflo(qraw[d0].y) * rs * w0.z, bfhi(qraw[d0].y) * rs * w0.w);
            o.z = cvtpk(bflo(qraw[d0].z) * rs * w1.x, bfhi(qraw[d0].z) * rs * w1.y); o.w = cvtpk(bflo(qraw[d0].w) * rs * w1.z, bfhi(qraw[d0].w) * rs * w1.w);
            qr[d0] = __builtin_bit_cast(bf16x8, o);
        }
        f32x16 S[5];
#pragma unroll
        for (int c = 0; c < 5; ++c) {
            f32x16 p;
#pragma unroll
            for (int r = 0; r < 16; ++r) p[r] = 0.f;
#pragma unroll
            for (int d0 = 0; d0 < 4; ++d0) {
                const bf16x8 kf = *(const LAS bf16x8*)(lds + LDS_K + (32 * (j + c) + r32) * KPB + (16 * d0 + 8 * hi) * 2);
                p = __builtin_amdgcn_mfma_f32_32x32x16_bf16(kf, qr[d0], p, 0, 0, 0);
            }
            S[c] = p;
        }
#pragma unroll
        for (int r = 0; r < 16; ++r) { const int kl = crow(r, hi); if (!(kl > r32)) S[0][r] = NEG; if (!(kl <= r32)) S[4][r] = NEG; }
        if (n == 0) {
#pragma unroll
            for (int c = 0; c < 5; ++c) if (j + c < 4) {
#pragma unroll
                for (int r = 0; r < 16; ++r) S[c][r] = NEG; }
        }
        float mx = sink2;
#pragma unroll
        for (int c = 0; c < 5; ++c)
#pragma unroll
            for (int r = 0; r < 16; ++r) mx = fmaxf(mx, S[c][r]);
        mx = fmaxf(mx, __shfl_xor(mx, 32));
        float l = 0.f;
#pragma unroll
        for (int c = 0; c < 5; ++c)
#pragma unroll
            for (int r = 0; r < 16; ++r) { const float p = __builtin_amdgcn_exp2f(S[c][r] - mx); S[c][r] = p; l += p; }
        l += __shfl_xor(l, 32);
        l += __builtin_amdgcn_exp2f(sink2 - mx);
        f32x16 o0, o1;
#pragma unroll
        for (int r = 0; r < 16; ++r) { o0[r] = 0.f; o1[r] = 0.f; }
#pragma unroll
        for (int c = 0; c < 5; ++c)
#pragma unroll
            for (int s = 0; s < 2; ++s) {
                u32x4 pw; pw.x = cvtpk(S[c][8 * s + 0], S[c][8 * s + 1]); pw.y = cvtpk(S[c][8 * s + 2], S[c][8 * s + 3]); pw.z = cvtpk(S[c][8 * s + 4], S[c][8 * s + 5]); pw.w = cvtpk(S[c][8 * s + 6], S[c][8 * s + 7]);
                const bf16x8 pa = __builtin_bit_cast(bf16x8, pw);
                const int kv0 = 32 * (j + c) + 16 * s + 4 * hi;
                { const LAS unsigned char* va = lds + LDS_V + (r32 * VP + kv0) * 2;
                  const u32x2 lo = *(const LAS u32x2*)va, hh = *(const LAS u32x2*)(va + 16);
                  const u32x4 vb = {lo.x, lo.y, hh.x, hh.y};
                  o0 = __builtin_amdgcn_mfma_f32_32x32x16_bf16(pa, __builtin_bit_cast(bf16x8, vb), o0, 0, 0, 0); }
                { const LAS unsigned char* va = lds + LDS_V + ((32 + r32) * VP + kv0) * 2;
                  const u32x2 lo = *(const LAS u32x2*)va, hh = *(const LAS u32x2*)(va + 16);
                  const u32x4 vb = {lo.x, lo.y, hh.x, hh.y};
                  o1 = __builtin_amdgcn_mfma_f32_32x32x16_bf16(pa, __builtin_bit_cast(bf16x8, vb), o1, 0, 0, 0); }
            }
        if (hi == 0) wsf[r32] = __builtin_amdgcn_rcpf(l);
        asm volatile("s_waitcnt lgkmcnt(0)" ::: "memory");
#pragma unroll
        for (int r = 0; r < 16; ++r) { const int orow = crow(r, hi); const float rl = wsf[orow];
            stg[orow * 64 + r32] = (bf16_t)(cvtpk(o0[r] * rl, 0.f) & 0xffffu); stg[orow * 64 + 32 + r32] = (bf16_t)(cvtpk(o1[r] * rl, 0.f) & 0xffffu); }
        asm volatile("s_waitcnt lgkmcnt(0)" ::: "memory");
#pragma unroll
        for (int i = 0; i < 4; ++i) { const int row = i * 8 + (lane >> 3), ch = lane & 7; const u32x4 v = *(const LAS u32x4*)(stg + row * 64 + ch * 8);
            *(u32x4*)(P + (rowbase + T0 + 32 * j + row) * NP + PC_Q + h * 64 + ch * 8) = v; }
        asm volatile("s_waitcnt lgkmcnt(0)" ::: "memory");
    }
    __syncthreads();
}
}

__device__ __forceinline__ void conv_pass(bf16_t* P, const float* cw, int gtid, int nthreads) {
    for (int it = gtid; it < (M / 16) * 128; it += nthreads) {
        const int c8 = (it & 127) * 8; const size_t r0 = (size_t)(it >> 7) * 16; const int t0 = (int)(r0 & (SEQ - 1));
        float w0[8], w1[8], w2[8], z1[8], z2[8];
        { const f32x4 a = *(const f32x4*)(cw + c8), b = *(const f32x4*)(cw + c8 + 4); w0[0] = a.x; w0[1] = a.y; w0[2] = a.z; w0[3] = a.w; w0[4] = b.x; w0[5] = b.y; w0[6] = b.z; w0[7] = b.w; }
        { const f32x4 a = *(const f32x4*)(cw + D + c8), b = *(const f32x4*)(cw + D + c8 + 4); w1[0] = a.x; w1[1] = a.y; w1[2] = a.z; w1[3] = a.w; w1[4] = b.x; w1[5] = b.y; w1[6] = b.z; w1[7] = b.w; }
        { const f32x4 a = *(const f32x4*)(cw + 2 * D + c8), b = *(const f32x4*)(cw + 2 * D + c8 + 4); w2[0] = a.x; w2[1] = a.y; w2[2] = a.z; w2[3] = a.w; w2[4] = b.x; w2[5] = b.y; w2[6] = b.z; w2[7] = b.w; }
        if (t0 == 0) {
#pragma unroll
            for (int e = 0; e < 8; ++e) { z1[e] = 0.f; z2[e] = 0.f; }
        } else {
            const bf16_t* pa = P + (r0 - 2) * NP + c8; const bf16_t* pb = P + (r0 - 1) * NP + c8;
            const u32x4 ca = *(const u32x4*)(pa + PC_C), va = *(const u32x4*)(pa + PC_VC), cb = *(const u32x4*)(pb + PC_C), vb = *(const u32x4*)(pb + PC_VC);
#pragma unroll
            for (int e = 0; e < 4; ++e) { z2[2 * e] = bflo(ca[e]) * bflo(va[e]); z2[2 * e + 1] = bfhi(ca[e]) * bfhi(va[e]); z1[2 * e] = bflo(cb[e]) * bflo(vb[e]); z1[2 * e + 1] = bfhi(cb[e]) * bfhi(vb[e]); }
        }
#pragma unroll 4
        for (int rr = 0; rr < 16; ++rr) {
            bf16_t* pr = P + (r0 + rr) * NP + c8;
            const u32x4 cc = *(const u32x4*)(pr + PC_C), vv = *(const u32x4*)(pr + PC_VC), bb = *(const u32x4*)(pr + PC_B);
            float z0[8], y[8];
#pragma unroll
            for (int e = 0; e < 4; ++e) { z0[2 * e] = bflo(cc[e]) * bflo(vv[e]); z0[2 * e + 1] = bfhi(cc[e]) * bfhi(vv[e]); }
#pragma unroll
            for (int e = 0; e < 8; ++e) y[e] = w0[e] * z2[e] + w1[e] * z1[e] + w2[e] * z0[e];
            u32x4 o;
#pragma unroll
            for (int e = 0; e < 4; ++e) o[e] = cvtpk(bflo(bb[e]) * y[2 * e], bfhi(bb[e]) * y[2 * e + 1]);
            *(u32x4*)(pr + PC_B) = o;
#pragma unroll
            for (int e = 0; e < 8; ++e) { z2[e] = z1[e]; z1[e] = z0[e]; }
        }
    }
}

struct Args { const float* in[20]; float* out; unsigned char* ws; int ph_lo, ph_hi; };
enum { I_X = 0, I_N1, I_WG1, I_WU1, I_WD1, I_NM, I_WIN, I_CONVW, I_QN, I_KN, I_SINK, I_WCO, I_WAO, I_WBG, I_BBG, I_WOUT, I_N2, I_WG2, I_WU2, I_WD2 };

__global__ void __launch_bounds__(512, 2) fwd(Args a) {
    extern __shared__ __attribute__((aligned(16))) unsigned char lds_raw[];
    LAS unsigned char* lds = (LAS unsigned char*)lds_raw;
    const int tid = threadIdx.x, lane = tid & 63, wave = __builtin_amdgcn_readfirstlane(tid >> 6);
    const int G = gridDim.x, bx = blockIdx.x;
    const int vcu = (G % 8 == 0) ? (bx % 8) * (G / 8) + bx / 8 : bx;
    unsigned char* ws = a.ws;
    bf16_t* W1 = (bf16_t*)(ws + WS_W1); bf16_t* W2 = (bf16_t*)(ws + WS_W2); bf16_t* W3 = (bf16_t*)(ws + WS_W3); bf16_t* W4 = (bf16_t*)(ws + WS_W4);
    bf16_t* W5 = (bf16_t*)(ws + WS_W5); bf16_t* W6 = (bf16_t*)(ws + WS_W6); bf16_t* W7 = (bf16_t*)(ws + WS_W7);
    float* PART1 = (float*)(ws + WS_PART1); float* PART2 = (float*)(ws + WS_PART2);
    bf16_t* XN = (bf16_t*)(ws + WS_XN); bf16_t* P = (bf16_t*)(ws + WS_P); bf16_t* X2G = (bf16_t*)(ws + WS_X2G); bf16_t* HB = (bf16_t*)(ws + WS_H);
    const int lo = a.ph_lo, hi = a.ph_hi;
#ifndef PH_MASK
#define PH_MASK 0x1ff
#endif
#define IN(k) (((PH_MASK >> (k)) & 1) && lo <= (k) && (k) < hi)
#if MK_N_LAUNCHES == 1
#define SEAM(k) do { if (IN(k) && IN((k) + 1)) cg::this_grid().sync(); } while (0)
#else
#define SEAM(k) do { } while (0)
#endif

    if (IN(0)) {
        LAS float* scr = (LAS float*)(lds + wave * 16384);
        const int gw = vcu * 8 + wave, NGW = G * 8;
        constexpr int NB_FF = FF / 32, IT_GU = 16 * NB_FF, IT_DN = (FF / 64) * 32, IT_IN = 16 * 136, IT_BG = 16 * 64, IT_SQ = 16 * 32;
        constexpr int NITEMS = 4 * IT_GU + 2 * IT_DN + IT_IN + IT_BG + 3 * IT_SQ;
        for (int it = gw; it < NITEMS; it += NGW) {
            int r = it;
            if (r < 4 * IT_GU) {
                const int which = r / IT_GU; r -= which * IT_GU; const int kb = r / NB_FF, nb = r % NB_FF, n0 = nb * 32;
                const float* W = a.in[which == 0 ? I_WG1 : which == 1 ? I_WU1 : which == 2 ? I_WG2 : I_WU2];
                p0_transpose_item(W, FF, (which < 2) ? W1 : W6, D, 0, 256 * (n0 >> 7) + 128 * (which & 1) + (n0 & 127), kb * 64, n0, scr, lane); continue; }
            r -= 4 * IT_GU;
            if (r < 2 * IT_DN) { const int which = r / IT_DN; r -= which * IT_DN; const int kb = r / 32, nb = r % 32;
                p0_transpose_item(a.in[which ? I_WD2 : I_WD1], D, which ? W7 : W2, FF, 0, nb * 32, kb * 64, nb * 32, scr, lane); continue; }
            r -= 2 * IT_DN;
            if (r < IT_IN) { const int kb = r / 136, nb = r % 136, n0 = nb * 32;
                const int dr = n0 < 1024 ? n0 + 2048 : (n0 < 3072 ? n0 - 1024 : n0);
                p0_transpose_item(a.in[I_WIN], 4352, W3, D, 0, dr, kb * 64, n0, scr, lane); continue; }
            r -= IT_IN;
            if (r < IT_BG) { const int kb = r / 64, nb = r % 64; p0_transpose_item(a.in[I_WBG], 2048, W3, D, 0, PC_GC + nb * 32, kb * 64, nb * 32, scr, lane); continue; }
            r -= IT_BG;
            { const int which = r / IT_SQ; r -= which * IT_SQ; const int kb = r / 32, nb = r % 32;
              if (which == 0) p0_transpose_item(a.in[I_WCO], D, W4, 2048, 0, nb * 32, kb * 64, nb * 32, scr, lane);
              else if (which == 1) p0_transpose_item(a.in[I_WAO], D, W4, 2048, 1024, nb * 32, kb * 64, nb * 32, scr, lane);
              else p0_transpose_item(a.in[I_WOUT], D, W5, D, 0, nb * 32, kb * 64, nb * 32, scr, lane); }
        }
        const float* x = a.in[I_X]; const float* g1 = a.in[I_N1];
        f32x4 gv[4];
#pragma unroll
        for (int j = 0; j < 4; ++j) gv[j] = ((const f32x4*)g1)[64 * j + lane];
        for (int m = gw; m < M; m += NGW) {
            const f32x4* xr = (const f32x4*)(x + (size_t)m * D) + lane;
            f32x4 v[4]; float s = 0.f;
#pragma unroll
            for (int j = 0; j < 4; ++j) { v[j] = xr[64 * j]; s += (v[j].x * v[j].x + v[j].y * v[j].y) + (v[j].z * v[j].z + v[j].w * v[j].w); }
            const float rstd = rsqrtf(wave_sum(s) * (1.f / D) + EPS);
            u32x2* o8 = (u32x2*)(XN + (size_t)m * D) + lane;
#pragma unroll
            for (int j = 0; j < 4; ++j) { u32x2 o; o.x = cvtpk(v[j].x * rstd * gv[j].x, v[j].y * rstd * gv[j].y); o.y = cvtpk(v[j].z * rstd * gv[j].z, v[j].w * rstd * gv[j].w); o8[64 * j] = o; }
        }
        asm volatile("s_waitcnt vmcnt(0) lgkmcnt(0)" ::: "memory"); __syncthreads();
    }
    SEAM(0);
    if (IN(1)) { pg8::Gemm g{XN, W1, D, 2 * FF, D}; pg8::StaticOrder S; S.init(M, 2 * FF, G, bx); pg8::EpiSwiglu E{HB, nullptr}; pg8::gemm_phase(lds, g, S, E); }
    SEAM(1);
    if (IN(2)) { pg8::Gemm g{HB, W2, FF, D, FF}; pg8::StaticOrder S; S.init(M, D, G, bx); pg8::EpiResid E{a.in[I_X], a.out, 0.5f, XN, a.in[I_NM], PART1}; pg8::gemm_phase(lds, g, S, E); }
    SEAM(2);
    if (IN(3)) { pg8::Gemm g{XN, W3, D, NP, D}; pg8::StaticOrder S; S.init(M, NP, G, bx); pg8::EpiProj E{P, PART1, a.in[I_BBG]}; pg8::gemm_phase(lds, g, S, E); }
    SEAM(3);
    if (IN(4)) {
        conv_pass(P, a.in[I_CONVW], vcu * 512 + tid, G * 512);
        for (int unit = vcu; unit < 1024; unit += G) att::attn_unit(lds, P, a.in[I_QN], a.in[I_KN], a.in[I_SINK], unit, tid, wave, lane);
        asm volatile("s_waitcnt vmcnt(0) lgkmcnt(0)" ::: "memory"); __syncthreads();
    }
    SEAM(4);
    if (IN(5)) { pg8::Gemm g{P + PC_B, W4, NP, D, 2048}; pg8::StaticOrder S; S.init(M, D, G, bx); pg8::EpiMix E{P, XN}; pg8::gemm_phase(lds, g, S, E); }
    SEAM(5);
    if (IN(6)) { pg8::Gemm g{XN, W5, D, D, D}; pg8::StaticOrder S; S.init(M, D, G, bx); pg8::EpiResid E{a.out, a.out, 1.0f, X2G, a.in[I_N2], PART2}; pg8::gemm_phase(lds, g, S, E); }
    SEAM(6);
    if (IN(7)) { pg8::Gemm g{X2G, W6, D, 2 * FF, D}; pg8::StaticOrder S; S.init(M, 2 * FF, G, bx); pg8::EpiSwiglu E{HB, PART2}; pg8::gemm_phase(lds, g, S, E); }
    SEAM(7);
    if (IN(8)) { pg8::Gemm g{HB, W7, FF, D, FF}; pg8::StaticOrder S; S.init(M, D, G, bx); pg8::EpiResid E{a.out, a.out, 0.5f, nullptr, nullptr, nullptr}; pg8::gemm_phase(lds, g, S, E); }
#undef IN
#undef SEAM
}

extern "C" void kernel_launch(void* const* d_in, const int* in_sizes, int n_in, void* d_out, int out_size, void* d_ws, size_t ws_size, hipStream_t stream) {
    static int grid = 0;
    if (grid == 0) {
        if (n_in != 20 || in_sizes[0] != M * D || out_size != M * D || ws_size < WS_END) { fprintf(stderr, "kernel_launch: unexpected shapes (n_in %d, in0 %d, out %d, ws %zu < %zu)\n", n_in, n_in > 0 ? in_sizes[0] : -1, out_size, ws_size, (size_t)WS_END); grid = -1; return; }
        int dev = 0, cus = 0, per_cu = 0;
        hipGetDevice(&dev); hipDeviceGetAttribute(&cus, hipDeviceAttributeMultiprocessorCount, dev);
        if (hipFuncSetAttribute((const void*)fwd, hipFuncAttributeMaxDynamicSharedMemorySize, LDS_BYTES) != hipSuccess) { fprintf(stderr, "kernel_launch: hipFuncSetAttribute failed\n"); grid = -1; return; }
        hipOccupancyMaxActiveBlocksPerMultiprocessor(&per_cu, (const void*)fwd, 512, LDS_BYTES);
        (void)hipGetLastError();
        if (per_cu < 1) per_cu = 1;
        grid = cus * 1;
        fprintf(stderr, "kernel_launch: cus %d per_cu %d grid %d\n", cus, per_cu, grid);
    }
    if (grid < 0) return;
    Args a{};
    for (int i = 0; i < 20; ++i) a.in[i] = (const float*)d_in[i];
    a.out = (float*)d_out; a.ws = (unsigned char*)d_ws;
#if MK_N_LAUNCHES == 1
    a.ph_lo = 0; a.ph_hi = 9;
    void* args[] = {&a};
    hipError_t e = hipLaunchCooperativeKernel((const void*)fwd, dim3(grid), dim3(512), args, LDS_BYTES, stream);
    if (e != hipSuccess) fprintf(stderr, "cooperative launch failed: %s (grid %d)\n", hipGetErrorString(e), grid);
#else
    for (int p = 0; p < 9; ++p) { a.ph_lo = p; a.ph_hi = p + 1; hipLaunchKernelGGL(fwd, dim3(grid), dim3(512), LDS_BYTES, stream, a); }
#endif
}
```

```cpp
#include <hip/hip_runtime.h>
#include <hip/hip_cooperative_groups.h>
#include <cstdio>
#include <cstdint>
namespace cg = cooperative_groups;

#ifndef MK_N_LAUNCHES
#define MK_N_LAUNCHES 1
#endif

#define LAS __attribute__((address_space(3)))
typedef unsigned short bf16_t;
typedef short bf16x8 __attribute__((ext_vector_type(8)));
typedef float f32x4 __attribute__((ext_vector_type(4)));
typedef float f32x16 __attribute__((ext_vector_type(16)));
typedef unsigned u32x4 __attribute__((ext_vector_type(4)));
typedef unsigned u32x2 __attribute__((ext_vector_type(2)));
typedef float f32x2_t __attribute__((ext_vector_type(2)));
typedef __bf16 bf16x2_t __attribute__((ext_vector_type(2)));

constexpr int M = 65536, D = 1024, FF = 2816, SEQ = 2048;
constexpr int NP = 6400;
constexpr int PC_C = 0, PC_VC = 1024, PC_B = 2048, PC_Q = 3072, PC_K = 4096, PC_V = 4224, PC_GC = 4352, PC_GA = 5376;
constexpr float EPS = 1e-6f;
constexpr float LOG2E = 1.4426950408889634f;

constexpr size_t MiB = 1u << 20;
constexpr size_t WS_W1 = 0;
constexpr size_t WS_W2 = 11 * MiB;
constexpr size_t WS_W3 = 17 * MiB;
constexpr size_t WS_W4 = 30 * MiB;
constexpr size_t WS_W5 = 34 * MiB;
constexpr size_t WS_W6 = 36 * MiB;
constexpr size_t WS_W7 = 47 * MiB;
constexpr size_t WS_PART1 = 53 * MiB;
constexpr size_t WS_PART2 = 57 * MiB;
constexpr size_t WS_XN = 64 * MiB;
constexpr size_t WS_P = 192 * MiB;
constexpr size_t WS_X2G = WS_P;
constexpr size_t WS_H = WS_P + 128 * MiB;
constexpr size_t WS_END = WS_P + 800 * MiB;

constexpr int RING_BYTES = 131072;
constexpr int LDS_BYTES = 147456;

__device__ __forceinline__ unsigned cvtpk(float lo, float hi) { f32x2_t v = {lo, hi}; bf16x2_t b = __builtin_convertvector(v, bf16x2_t); return __builtin_bit_cast(unsigned, b); }
__device__ __forceinline__ float bflo(unsigned w) { return __uint_as_float(w << 16); }
__device__ __forceinline__ float bfhi(unsigned w) { return __uint_as_float(w & 0xffff0000u); }
__device__ __forceinline__ float sigmoidf_(float z) { return __builtin_amdgcn_rcpf(1.f + __expf(-z)); }
__device__ __forceinline__ float rstd_from_parts(const float* p) {
    const f32x4 a = *(const f32x4*)p;
    return rsqrtf(((a.x + a.y) + (a.z + a.w)) * (1.0f / 1024.0f) + EPS);
}

namespace pg8 {
constexpr int BM = 256, BK = 64, HALF = 128, HTB = HALF * BK * 2, STAGE_BYTES = 8 * HTB, NXCD = 8, WGM = 8;
__host__ __device__ __forceinline__ int lds_byte(int r, int c) { const int st = (r >> 4) * 2 + (c >> 5), rr = r & 15, cc = c & 31, ob = rr * 64 + cc * 2; return st * 1024 + (ob ^ (((ob >> 9) & 1) << 5)); }
__host__ __device__ __forceinline__ void stage_rc(int b, int& R, int& C) { const int st = b / 1024, sb = b % 1024, swz = sb ^ (((sb >> 9) & 1) << 5); R = (st >> 1) * 16 + swz / 64; C = (st & 1) * 32 + (swz % 64) / 2; }
__host__ __device__ __forceinline__ int perm32(int rho) { const int n = rho >> 4, i = rho & 15; return 8 * (i >> 2) + 4 * n + (i & 3); }

struct Unit { int pm, pn; };
struct Gemm { const bf16_t* A; const bf16_t* Bt; int lda, N, K; };

struct StaticOrder {
    int nM, nN, nwg, G, c;
    __device__ void init(int Mr, int N, int G_, int c_) { nM = Mr / BM; nN = N / BM; nwg = nM * nN; G = G_; c = c_; }
    __device__ bool next(int i, Unit& u) const {
        const long L = (long)i * G + c; if (L >= nwg) return false;
        int wgid = (int)L; { const int q = nwg / NXCD, r = nwg % NXCD, xcd = wgid % NXCD, off = wgid / NXCD; wgid = (xcd < r ? xcd * (q + 1) : r * (q + 1) + (xcd - r) * q) + off; }
        const int nig = WGM * nN, gid = wgid / nig, fm = gid * WGM, gsz = (nM - fm) < WGM ? (nM - fm) : WGM;
        u.pm = fm + ((wgid % nig) % gsz); u.pn = (wgid % nig) / gsz; return true;
    }
};

typedef f32x4 Acc[2][2][4][2];

struct EpiSwiglu {
    static constexpr bool HAS_MID = false; static constexpr int MID_T = -1;
    bf16_t* H; const float* part;
    __device__ __forceinline__ void mid(Acc&, const Unit&, int, int, int, int) const {}
    __device__ __forceinline__ void operator()(const Acc& acc, const Unit& u, int wr, int wc, int fr, int fq) const {
        const int row0 = u.pm * BM + wr * 64 + fr, col0 = u.pn * HALF + wc * 32 + 8 * fq;
#pragma unroll
        for (int ai = 0; ai < 2; ++ai)
#pragma unroll
            for (int m = 0; m < 4; ++m) {
                const int row = row0 + ai * HALF + m * 16;
                const float rs = part ? rstd_from_parts(part + (size_t)row * 4) : 1.0f;
                float h[8];
#pragma unroll
                for (int n = 0; n < 2; ++n)
#pragma unroll
                    for (int i = 0; i < 4; ++i) { const float g = acc[ai][0][m][n][i] * rs, up = acc[ai][1][m][n][i] * rs; h[4 * n + i] = g * sigmoidf_(g) * up; }
                u32x4 w; w.x = cvtpk(h[0], h[1]); w.y = cvtpk(h[2], h[3]); w.z = cvtpk(h[4], h[5]); w.w = cvtpk(h[6], h[7]);
                *(u32x4*)(H + (size_t)row * FF + col0) = w;
            }
    }
};

template <int MODE> struct EpiResid {
    static constexpr bool HAS_MID = false; static constexpr int MID_T = -1;
    const float* basef; const bf16_t* baseb; float* outf; bf16_t* outb; float alpha; float* part; LAS float* red;
    __device__ __forceinline__ void mid(Acc&, const Unit&, int, int, int, int) const {}
    __device__ __forceinline__ void operator()(const Acc& acc, const Unit& u, int wr, int wc, int fr, int fq) const {
        const int row0 = u.pm * BM + wr * 64 + fr, col0 = u.pn * BM + wc * 32 + 8 * fq;
#pragma unroll
        for (int ai = 0; ai < 2; ++ai)
#pragma unroll
            for (int m = 0; m < 4; ++m) {
                const int row = row0 + ai * HALF + m * 16; float ss = 0.f;
#pragma unroll
                for (int bj = 0; bj < 2; ++bj) {
                    const size_t off = (size_t)row * D + col0 + bj * HALF;
                    f32x4 b0, b1;
                    if (MODE == 0) { b0 = *(const f32x4*)(basef + off); b1 = *(const f32x4*)(basef + off + 4); }
                    else { const u32x4 w = *(const u32x4*)(baseb + off); b0 = (f32x4){bflo(w.x), bfhi(w.x), bflo(w.y), bfhi(w.y)}; b1 = (f32x4){bflo(w.z), bfhi(w.z), bflo(w.w), bfhi(w.w)}; }
                    const f32x4 v0 = b0 + acc[ai][bj][m][0] * alpha, v1 = b1 + acc[ai][bj][m][1] * alpha;
                    if (MODE == 2) { *(f32x4*)(outf + off) = v0; *(f32x4*)(outf + off + 4) = v1; }
                    else {
                        ss += (v0.x * v0.x + v0.y * v0.y) + (v0.z * v0.z + v0.w * v0.w) + (v1.x * v1.x + v1.y * v1.y) + (v1.z * v1.z + v1.w * v1.w);
                        u32x4 w; w.x = cvtpk(v0.x, v0.y); w.y = cvtpk(v0.z, v0.w); w.z = cvtpk(v1.x, v1.y); w.w = cvtpk(v1.z, v1.w); *(u32x4*)(outb + off) = w;
                    }
                }
                if (MODE != 2) { ss += __shfl_xor(ss, 16); ss += __shfl_xor(ss, 32); if (fq == 0) red[(ai * HALF + wr * 64 + m * 16 + fr) * 4 + wc] = ss; }
            }
        if (MODE != 2) {
            asm volatile("s_waitcnt lgkmcnt(0)" ::: "memory"); __builtin_amdgcn_s_barrier(); asm volatile("" ::: "memory");
            const int t = threadIdx.x;
            if (t < 256) { const f32x4 r = *(const LAS f32x4*)(red + t * 4); part[(size_t)(u.pm * BM + t) * 4 + u.pn] = (r.x + r.y) + (r.z + r.w); }
            asm volatile("s_waitcnt lgkmcnt(0)" ::: "memory"); __builtin_amdgcn_s_barrier(); asm volatile("" ::: "memory");
        }
    }
};

struct EpiProj {
    static constexpr bool HAS_MID = false; static constexpr int MID_T = -1;
    bf16_t* P; const float* part; const float* bias;
    __device__ __forceinline__ void mid(Acc&, const Unit&, int, int, int, int) const {}
    __device__ __forceinline__ void operator()(const Acc& acc, const Unit& u, int wr, int wc, int fr, int fq) const {
        const int row0 = u.pm * BM + wr * 64 + fr, col0 = u.pn * BM + wc * 32 + 8 * fq; const bool gate = u.pn >= 17;
        f32x4 bv[2][2];
#pragma unroll
        for (int bj = 0; bj < 2; ++bj)
#pragma unroll
            for (int n = 0; n < 2; ++n) bv[bj][n] = gate ? *(const f32x4*)(bias + (col0 - PC_GC) + bj * HALF + 4 * n) : (f32x4){0.f, 0.f, 0.f, 0.f};
#pragma unroll
        for (int ai = 0; ai < 2; ++ai)
#pragma unroll
            for (int m = 0; m < 4; ++m) {
                const int row = row0 + ai * HALF + m * 16; const float rs = rstd_from_parts(part + (size_t)row * 4);
#pragma unroll
                for (int bj = 0; bj < 2; ++bj) {
                    f32x4 v0 = acc[ai][bj][m][0] * rs + bv[bj][0], v1 = acc[ai][bj][m][1] * rs + bv[bj][1];
                    if (gate) { v0.x = sigmoidf_(v0.x); v0.y = sigmoidf_(v0.y); v0.z = sigmoidf_(v0.z); v0.w = sigmoidf_(v0.w); v1.x = sigmoidf_(v1.x); v1.y = sigmoidf_(v1.y); v1.z = sigmoidf_(v1.z); v1.w = sigmoidf_(v1.w); }
                    u32x4 w; w.x = cvtpk(v0.x, v0.y); w.y = cvtpk(v0.z, v0.w); w.z = cvtpk(v1.x, v1.y); w.w = cvtpk(v1.z, v1.w);
                    *(u32x4*)(P + (size_t)row * NP + col0 + bj * HALF) = w;
                }
            }
    }
};

struct EpiMix {
    static constexpr bool HAS_MID = true; static constexpr int MID_T = 16;
    const bf16_t* P; bf16_t* out;
    __device__ __forceinline__ void mid(Acc& acc, const Unit& u, int wr, int wc, int fr, int fq) const {
        int row0 = u.pm * BM + wr * 64 + fr; const int col0 = u.pn * BM + wc * 32 + 8 * fq;
        asm volatile("" : "+v"(row0));
#pragma unroll
        for (int ai = 0; ai < 2; ++ai)
#pragma unroll
            for (int m = 0; m < 4; ++m) {
                const int row = row0 + ai * HALF + m * 16;
#pragma unroll
                for (int bj = 0; bj < 2; ++bj) {
                    const bf16_t* pr = P + (size_t)row * NP + col0 + bj * HALF;
                    const u32x4 gc = *(const u32x4*)(pr + PC_GC), ga = *(const u32x4*)(pr + PC_GA);
                    f32x4 r0, r1;
                    r0.x = bflo(gc.x) * __builtin_amdgcn_rcpf(fmaxf(bflo(ga.x), 1e-30f)); r0.y = bfhi(gc.x) * __builtin_amdgcn_rcpf(fmaxf(bfhi(ga.x), 1e-30f));
                    r0.z = bflo(gc.y) * __builtin_amdgcn_rcpf(fmaxf(bflo(ga.y), 1e-30f)); r0.w = bfhi(gc.y) * __builtin_amdgcn_rcpf(fmaxf(bfhi(ga.y), 1e-30f));
                    r1.x = bflo(gc.z) * __builtin_amdgcn_rcpf(fmaxf(bflo(ga.z), 1e-30f)); r1.y = bfhi(gc.z) * __builtin_amdgcn_rcpf(fmaxf(bfhi(ga.z), 1e-30f));
                    r1.z = bflo(gc.w) * __builtin_amdgcn_rcpf(fmaxf(bflo(ga.w), 1e-30f)); r1.w = bfhi(gc.w) * __builtin_amdgcn_rcpf(fmaxf(bfhi(ga.w), 1e-30f));
                    acc[ai][bj][m][0] *= r0; acc[ai][bj][m][1] *= r1;
                }
                if (m & 1) asm volatile("" ::: "memory");
            }
    }
    __device__ __forceinline__ void operator()(const Acc& acc, const Unit& u, int wr, int wc, int fr, int fq) const {
        const int row0 = u.pm * BM + wr * 64 + fr, col0 = u.pn * BM + wc * 32 + 8 * fq;
#pragma unroll
        for (int ai = 0; ai < 2; ++ai)
#pragma unroll
            for (int m = 0; m < 4; ++m) {
                const int row = row0 + ai * HALF + m * 16;
#pragma unroll
                for (int bj = 0; bj < 2; ++bj) {
                    const u32x4 ga = *(const u32x4*)(P + (size_t)row * NP + col0 + bj * HALF + PC_GA);
                    f32x4 g0, g1;
                    g0.x = fmaxf(bflo(ga.x), 1e-30f); g0.y = fmaxf(bfhi(ga.x), 1e-30f); g0.z = fmaxf(bflo(ga.y), 1e-30f); g0.w = fmaxf(bfhi(ga.y), 1e-30f);
                    g1.x = fmaxf(bflo(ga.z), 1e-30f); g1.y = fmaxf(bfhi(ga.z), 1e-30f); g1.z = fmaxf(bflo(ga.w), 1e-30f); g1.w = fmaxf(bfhi(ga.w), 1e-30f);
                    const f32x4 v0 = acc[ai][bj][m][0] * g0, v1 = acc[ai][bj][m][1] * g1;
                    u32x4 w; w.x = cvtpk(v0.x, v0.y); w.y = cvtpk(v0.z, v0.w); w.z = cvtpk(v1.x, v1.y); w.w = cvtpk(v1.z, v1.w);
                    *(u32x4*)(out + (size_t)row * D + col0 + bj * HALF) = w;
                }
            }
    }
};

template <class Epi>
__device__ __forceinline__ void gemm_phase(LAS unsigned char* lds, const Gemm g, const StaticOrder& S, const Epi& E) {
    const int tid = threadIdx.x, wid = __builtin_amdgcn_readfirstlane(tid >> 6), lane = tid & 63, wr = wid >> 2, wc = wid & 3, fr = lane & 15, fq = lane >> 4;
    const int K = g.K, nt = K / BK, lda = g.lda;
    unsigned voffA[2], voffB[2];
#pragma unroll
    for (int i = 0; i < 2; ++i) { int R, C; stage_rc(tid * 16 + i * 8192, R, C); const int Rb = (R & ~31) + perm32(R & 31);
        voffA[i] = (unsigned)(R * lda + C) * 2u; voffB[i] = (unsigned)(Rb * K + C) * 2u; }
    const size_t kstep = (size_t)(BK * 2);
    const size_t hstepA = (size_t)HALF * lda * 2, hstepB = (size_t)HALF * K * 2;
    const size_t tstepA = 2 * hstepA, tstepB = 2 * hstepB;
    const unsigned ldsw = (unsigned)wid * 1024u;
    const int aoff = lds_byte(wr * 64 + fr, fq * 8), boff = lds_byte(wc * 32 + fr, fq * 8);
#define PG8_SA(b, h) (((b) * 2 + (h)) * HTB)
#define PG8_SB(b, h) ((4 + (b) * 2 + (h)) * HTB)
#define PG8_STAGE(bufoff, gbase, voff) do { _Pragma("unroll") for (int _i = 0; _i < 2; ++_i) \
        __builtin_amdgcn_global_load_lds((const unsigned*)((const char*)(gbase) + (voff)[_i]), (LAS unsigned*)(lds + (bufoff) + ldsw + _i * 8192), 16, 0, 0); } while (0)
#define PG8_LDA(dst, b, h) do { _Pragma("unroll") for (int m = 0; m < 4; ++m) _Pragma("unroll") for (int k = 0; k < 2; ++k) dst[m][k] = *(const LAS bf16x8*)(lds + PG8_SA(b, h) + aoff + m * 2048 + k * 1024); } while (0)
#define PG8_LDB(dst, b, h) do { _Pragma("unroll") for (int n = 0; n < 2; ++n) _Pragma("unroll") for (int k = 0; k < 2; ++k) dst[n][k] = *(const LAS bf16x8*)(lds + PG8_SB(b, h) + boff + n * 2048 + k * 1024); } while (0)
#define PG8_MMA(ai, bj, At, Bt) do { __builtin_amdgcn_s_setprio(1); _Pragma("unroll") for (int m = 0; m < 4; ++m) _Pragma("unroll") for (int n = 0; n < 2; ++n) _Pragma("unroll") for (int k = 0; k < 2; ++k) \
        acc[ai][bj][m][n] = __builtin_amdgcn_mfma_f32_16x16x32_bf16(Bt[n][k], At[m][k], acc[ai][bj][m][n], 0, 0, 0); __builtin_amdgcn_s_setprio(0); } while (0)
#define PG8_WAIT_V(n) asm volatile("s_waitcnt vmcnt(" #n ")" ::: "memory")
#define PG8_WAIT_L(n) asm volatile("s_waitcnt lgkmcnt(" #n ")" ::: "memory")
#define PG8_BAR __builtin_amdgcn_s_barrier()
#define PG8_SCHED __builtin_amdgcn_sched_barrier(0)
    Unit cur, nxt; int ui = 0;
    if (!S.next(0, cur)) return;
    Acc acc;
#pragma unroll
    for (int a = 0; a < 2; ++a)
#pragma unroll
        for (int b = 0; b < 2; ++b)
#pragma unroll
            for (int m = 0; m < 4; ++m)
#pragma unroll
                for (int n = 0; n < 2; ++n) acc[a][b][m][n] = (f32x4){0.f, 0.f, 0.f, 0.f};
    bf16x8 At[4][2], B0[2][2], B1[2][2];
    const char* cA = (const char*)g.A + (size_t)cur.pm * tstepA; const char* cB = (const char*)g.Bt + (size_t)cur.pn * tstepB;
    PG8_STAGE(PG8_SB(0, 0), cB, voffB); PG8_STAGE(PG8_SB(0, 1), cB + hstepB, voffB); PG8_STAGE(PG8_SA(0, 0), cA, voffA); PG8_STAGE(PG8_SA(0, 1), cA + hstepA, voffA);
    if (wr == 1) PG8_BAR;
    PG8_WAIT_V(2); PG8_BAR;
    PG8_STAGE(PG8_SB(1, 0), cB + kstep, voffB); PG8_STAGE(PG8_SA(1, 0), cA + kstep, voffA); PG8_STAGE(PG8_SB(1, 1), cB + hstepB + kstep, voffB);
    PG8_WAIT_V(6); PG8_BAR;
    for (;;) {
        const bool has_next = S.next(ui + 1, nxt);
        const char* nA = has_next ? (const char*)g.A + (size_t)nxt.pm * tstepA : cA; const char* nB = has_next ? (const char*)g.Bt + (size_t)nxt.pn * tstepB : cB;
        for (int t = 0; t < nt; t += 2) {
            if constexpr (Epi::HAS_MID) { if (t == Epi::MID_T) { E.mid(acc, cur, wr, wc, fr, fq); PG8_SCHED; } }
            const bool last = (t == nt - 2);
            const char* a1 = cA + (size_t)(t + 1) * kstep;
            const char* a2 = last ? nA : cA + (size_t)(t + 2) * kstep; const char* b2 = last ? nB : cB + (size_t)(t + 2) * kstep;
            const char* a3 = a2 + kstep; const char* b3 = b2 + kstep;
            PG8_LDB(B0, 0, 0); PG8_LDB(B1, 0, 1); PG8_SCHED; PG8_LDA(At, 0, 0); PG8_STAGE(PG8_SA(1, 1), a1 + hstepA, voffA);
            PG8_WAIT_V(8); PG8_WAIT_L(0); PG8_BAR; PG8_MMA(0, 0, At, B0); PG8_MMA(0, 1, At, B1); PG8_BAR; PG8_SCHED;
            PG8_LDA(At, 0, 1); PG8_STAGE(PG8_SB(0, 0), b2, voffB); PG8_STAGE(PG8_SB(0, 1), b2 + hstepB, voffB); PG8_STAGE(PG8_SA(0, 0), a2, voffA);
            PG8_WAIT_V(8); PG8_WAIT_L(0); PG8_BAR; PG8_MMA(1, 0, At, B0); PG8_MMA(1, 1, At, B1); PG8_BAR; PG8_SCHED;
            PG8_LDB(B0, 1, 0); PG8_LDB(B1, 1, 1); PG8_SCHED; PG8_LDA(At, 1, 0); PG8_STAGE(PG8_SA(0, 1), a2 + hstepA, voffA);
            PG8_WAIT_V(8); PG8_WAIT_L(0); PG8_BAR; PG8_MMA(0, 0, At, B0); PG8_MMA(0, 1, At, B1); PG8_BAR; PG8_SCHED;
            PG8_LDA(At, 1, 1); PG8_STAGE(PG8_SB(1, 0), b3, voffB); PG8_STAGE(PG8_SB(1, 1), b3 + hstepB, voffB); PG8_STAGE(PG8_SA(1, 0), a3, voffA);
            PG8_WAIT_V(8); PG8_WAIT_L(0); PG8_BAR; PG8_MMA(1, 0, At, B0); PG8_MMA(1, 1, At, B1); PG8_BAR; PG8_SCHED;
        }
        if (wr == 0) PG8_BAR;
        E(acc, cur, wr, wc, fr, fq);
        if (!has_next) break;
#pragma unroll
        for (int a = 0; a < 2; ++a)
#pragma unroll
            for (int b = 0; b < 2; ++b)
#pragma unroll
                for (int m = 0; m < 4; ++m)
#pragma unroll
                    for (int n = 0; n < 2; ++n) acc[a][b][m][n] = (f32x4){0.f, 0.f, 0.f, 0.f};
        cur = nxt; cA = nA; cB = nB; ++ui;
        if (wr == 1) PG8_BAR;
    }
    PG8_WAIT_V(0);
    PG8_BAR;
#undef PG8_SA
#undef PG8_SB
#undef PG8_STAGE
#undef PG8_LDA
#undef PG8_LDB
#undef PG8_MMA
#undef PG8_WAIT_V
#undef PG8_WAIT_L
#undef PG8_BAR
#undef PG8_SCHED
}
}

__device__ __forceinline__ float wave_sum(float v) {
#pragma unroll
    for (int o = 1; o < 64; o <<= 1) v += __shfl_xor(v, o);
    return v;
}
__device__ __forceinline__ void p0_transpose_item(const float* W, int N, bf16_t* WT, int ldk, int koff, int drow0, int k0, int n0, LAS float* scr, int lane, const float* ksc = nullptr) {
#pragma unroll 8
    for (int i = 0; i < 32; ++i) { const int kk = 2 * i + (lane >> 5); const float sc = ksc ? ksc[k0 + kk] : 1.0f; scr[kk * 33 + (lane & 31)] = W[(size_t)(k0 + kk) * N + n0 + (lane & 31)] * sc; }
    asm volatile("s_waitcnt lgkmcnt(0)" ::: "memory");
    const int c = lane & 7;
#pragma unroll
    for (int j = 0; j < 4; ++j) { const int n = (lane >> 3) + 8 * j; const LAS float* s = scr + (8 * c) * 33 + n;
        u32x4 o; o.x = cvtpk(s[0 * 33], s[1 * 33]); o.y = cvtpk(s[2 * 33], s[3 * 33]); o.z = cvtpk(s[4 * 33], s[5 * 33]); o.w = cvtpk(s[6 * 33], s[7 * 33]);
        *(u32x4*)(WT + (size_t)(drow0 + n) * ldk + koff + k0 + 8 * c) = o; }
    asm volatile("s_waitcnt lgkmcnt(0)" ::: "memory");
}

namespace att {
constexpr int KPB = 144;
constexpr int VP = 260;
constexpr int LDS_K = 0, LDS_V = 36864, LDS_WS = 70144, LDS_OST = 72192, LDS_END = 104960;
__device__ __forceinline__ int crow(int r, int hi) { return (r & 3) + 8 * (r >> 2) + 4 * hi; }

__device__ __forceinline__ void attn_unit(LAS unsigned char* lds, bf16_t* P, const float* qn_w, const float* kn_w, const float* sinks, int unit, int tid, int wid, int lane) {
    const int hk = unit & 1, n = (unit >> 1) & 15, b = unit >> 5;
    const int T0 = n * 128; const size_t rowbase = (size_t)b * SEQ;
    {
        const int kk = tid >> 1, half = tid & 1; const int kp = T0 - 128 + kk;
        u32x4 kr[4], vr[4];
        if (kp >= 0) { const bf16_t* pr = P + (rowbase + kp) * NP + PC_K + hk * 64 + half * 32;
#pragma unroll
            for (int i = 0; i < 4; ++i) { kr[i] = *(const u32x4*)(pr + 8 * i); vr[i] = *(const u32x4*)(pr + 128 + 8 * i); } }
        else {
#pragma unroll
            for (int i = 0; i < 4; ++i) { kr[i] = (u32x4){0u, 0u, 0u, 0u}; vr[i] = (u32x4){0u, 0u, 0u, 0u}; } }
        float ss = 0.f;
#pragma unroll
        for (int i = 0; i < 4; ++i)
#pragma unroll
            for (int e = 0; e < 4; ++e) { const float a = bflo(kr[i][e]), c = bfhi(kr[i][e]); ss += a * a + c * c; }
        ss += __shfl_xor(ss, 1);
        const float rs = rsqrtf(ss * (1.0f / 64.0f) + EPS);
#pragma unroll
        for (int i = 0; i < 4; ++i) {
            const f32x4 w0 = *(const f32x4*)(kn_w + half * 32 + 8 * i), w1 = *(const f32x4*)(kn_w + half * 32 + 8 * i + 4);
            u32x4 o;
            o.x = cvtpk(bflo(kr[i].x) * rs * w0.x, bfhi(kr[i].x) * rs * w0.y); o.y = cvtpk(bflo(kr[i].y) * rs * w0.z, bfhi(kr[i].y) * rs * w0.w);
            o.z = cvtpk(bflo(kr[i].z) * rs * w1.x, bfhi(kr[i].z) * rs * w1.y); o.w = cvtpk(bflo(kr[i].w) * rs * w1.z, bfhi(kr[i].w) * rs * w1.w);
            *(LAS u32x4*)(lds + LDS_K + kk * KPB + half * 64 + 16 * i) = o;
        }
#pragma unroll
        for (int i = 0; i < 4; ++i)
#pragma unroll
            for (int e = 0; e < 8; ++e) {
                const unsigned short val = (unsigned short)((vr[i][e >> 1] >> (16 * (e & 1))) & 0xffffu);
                *(LAS unsigned short*)(lds + LDS_V + ((half * 32 + 8 * i + e) * VP + kk) * 2) = val;
            }
    }
    __syncthreads();
    const int h = hk * 8 + wid, r32 = lane & 31, hi = lane >> 5;
    const float sink2 = sinks[h] * LOG2E;
    LAS float* wsf = (LAS float*)(lds + LDS_WS) + wid * 64;
    LAS bf16_t* stg = (LAS bf16_t*)(lds + LDS_OST) + wid * 2048;
    const float NEG = -1e30f;
#pragma unroll 1
    for (int j = 0; j < 4; ++j) {
        bf16_t* qp = P + (rowbase + T0 + 32 * j + r32) * NP + PC_Q + h * 64;
        u32x4 qraw[4]; float ss = 0.f;
#pragma unroll
        for (int d0 = 0; d0 < 4; ++d0) { qraw[d0] = *(const u32x4*)(qp + 16 * d0 + 8 * hi);
#pragma unroll
            for (int e = 0; e < 4; ++e) { const float a = bflo(qraw[d0][e]), c = bfhi(qraw[d0][e]); ss += a * a + c * c; } }
        ss += __shfl_xor(ss, 32);
        const float rs = rsqrtf(ss * (1.0f / 64.0f) + EPS) * (0.125f * LOG2E);
        bf16x8 qr[4];
#pragma unroll
        for (int d0 = 0; d0 < 4; ++d0) {
            const f32x4 w0 = *(const f32x4*)(qn_w + 16 * d0 + 8 * hi), w1 = *(const f32x4*)(qn_w + 16 * d0 + 8 * hi + 4);
            u32x4 o;
            o.x = cvtpk(bflo(qraw[d0].x) * rs * w0.x, bfhi(qraw[d0].x) * rs * w0.y); o.y = cvtpk(bflo(qraw[d0].y) * rs * w0.z, bfhi(qraw[d0].y) * rs * w0.w);
            o.z = cvtpk(bflo(qraw[d0].z) * rs * w1.x, bfhi(qraw[d0].z) * rs * w1.y); o.w = cvtpk(bflo(qraw[d0].w) * rs * w1.z, bfhi(qraw[d0].w) * rs * w1.w);
            qr[d0] = __builtin_bit_cast(bf16x8, o);
        }
        f32x16 S[5];
#pragma unroll
        for (int c = 0; c < 5; ++c) {
            f32x16 p;
#pragma unroll
            for (int r = 0; r < 16; ++r) p[r] = 0.f;
#pragma unroll
            for (int d0 = 0; d0 < 4; ++d0) {
                const bf16x8 kf = *(const LAS bf16x8*)(lds + LDS_K + (32 * (j + c) + r32) * KPB + (16 * d0 + 8 * hi) * 2);
                p = __builtin_amdgcn_mfma_f32_32x32x16_bf16(kf, qr[d0], p, 0, 0, 0);
            }
            S[c] = p;
        }
#pragma unroll
        for (int r = 0; r < 16; ++r) { const int kl = crow(r, hi); if (!(kl > r32)) S[0][r] = NEG; if (!(kl <= r32)) S[4][r] = NEG; }
        if (n == 0) {
#pragma unroll
            for (int c = 0; c < 5; ++c) if (j + c < 4) {
#pragma unroll
                for (int r = 0; r < 16; ++r) S[c][r] = NEG; }
        }
        float mx = sink2;
#pragma unroll
        for (int c = 0; c < 5; ++c)
#pragma unroll
            for (int r = 0; r < 16; ++r) mx = fmaxf(mx, S[c][r]);
        mx = fmaxf(mx, __shfl_xor(mx, 32));
        float l = 0.f;
#pragma unroll
        for (int c = 0; c < 5; ++c)
#pragma unroll
            for (int r = 0; r < 16; ++r) { const float p = __builtin_amdgcn_exp2f(S[c][r] - mx); S[c][r] = p; l += p; }
        l += __shfl_xor(l, 32);
        l += __builtin_amdgcn_exp2f(sink2 - mx);
        f32x16 o0, o1;
#pragma unroll
        for (int r = 0; r < 16; ++r) { o0[r] = 0.f; o1[r] = 0.f; }
#pragma unroll
        for (int c = 0; c < 5; ++c)
#pragma unroll
            for (int s = 0; s < 2; ++s) {
                u32x4 pw; pw.x = cvtpk(S[c][8 * s + 0], S[c][8 * s + 1]); pw.y = cvtpk(S[c][8 * s + 2], S[c][8 * s + 3]); pw.z = cvtpk(S[c][8 * s + 4], S[c][8 * s + 5]); pw.w = cvtpk(S[c][8 * s + 6], S[c][8 * s + 7]);
                const bf16x8 pa = __builtin_bit_cast(bf16x8, pw);
                const int kv0 = 32 * (j + c) + 16 * s + 4 * hi;
                { const LAS unsigned char* va = lds + LDS_V + (r32 * VP + kv0) * 2;
                  const u32x2 lo = *(const LAS u32x2*)va, hh = *(const LAS u32x2*)(va + 16);
                  const u32x4 vb = {lo.x, lo.y, hh.x, hh.y};
                  o0 = __builtin_amdgcn_mfma_f32_32x32x16_bf16(pa, __builtin_bit_cast(bf16x8, vb), o0, 0, 0, 0); }
                { const LAS unsigned char* va = lds + LDS_V + ((32 + r32) * VP + kv0) * 2;
                  const u32x2 lo = *(const LAS u32x2*)va, hh = *(const LAS u32x2*)(va + 16);
                  const u32x4 vb = {lo.x, lo.y, hh.x, hh.y};
                  o1 = __builtin_amdgcn_mfma_f32_32x32x16_bf16(pa, __builtin_bit_cast(bf16x8, vb), o1, 0, 0, 0); }
            }
        if (hi == 0) wsf[r32] = __builtin_amdgcn_rcpf(l);
        asm volatile("s_waitcnt lgkmcnt(0)" ::: "memory");
#pragma unroll
        for (int r = 0; r < 16; ++r) { const int orow = crow(r, hi); const float rl = wsf[orow];
            stg[orow * 64 + r32] = (bf16_t)(cvtpk(o0[r] * rl, 0.f) & 0xffffu); stg[orow * 64 + 32 + r32] = (bf16_t)(cvtpk(o1[r] * rl, 0.f) & 0xffffu); }
        asm volatile("s_waitcnt lgkmcnt(0)" ::: "memory");
#pragma unroll
        for (int i = 0; i < 4; ++i) { const int row = i * 8 + (lane >> 3), ch = lane & 7; const u32x4 v = *(const LAS u32x4*)(stg + row * 64 + ch * 8);
            *(u32x4*)(P + (rowbase + T0 + 32 * j + row) * NP + PC_Q + h * 64 + ch * 8) = v; }
        asm volatile("s_waitcnt lgkmcnt(0)" ::: "memory");
    }
    __syncthreads();
}
}

__device__ __forceinline__ void conv_pass(bf16_t* P, const float* cw, int gtid, int nthreads) {
    for (int it = gtid; it < (M / 16) * 128; it += nthreads) {
        const int c8 = (it & 127) * 8; const size_t r0 = (size_t)(it >> 7) * 16; const int t0 = (int)(r0 & (SEQ - 1));
        float w0[8], w1[8], w2[8], z1[8], z2[8];
        { const f32x4 a = *(const f32x4*)(cw + c8), b = *(const f32x4*)(cw + c8 + 4); w0[0] = a.x; w0[1] = a.y; w0[2] = a.z; w0[3] = a.w; w0[4] = b.x; w0[5] = b.y; w0[6] = b.z; w0[7] = b.w; }
        { const f32x4 a = *(const f32x4*)(cw + D + c8), b = *(const f32x4*)(cw + D + c8 + 4); w1[0] = a.x; w1[1] = a.y; w1[2] = a.z; w1[3] = a.w; w1[4] = b.x; w1[5] = b.y; w1[6] = b.z; w1[7] = b.w; }
        { const f32x4 a = *(const f32x4*)(cw + 2 * D + c8), b = *(const f32x4*)(cw + 2 * D + c8 + 4); w2[0] = a.x; w2[1] = a.y; w2[2] = a.z; w2[3] = a.w; w2[4] = b.x; w2[5] = b.y; w2[6] = b.z; w2[7] = b.w; }
        if (t0 == 0) {
#pragma unroll
            for (int e = 0; e < 8; ++e) { z1[e] = 0.f; z2[e] = 0.f; }
        } else {
            const bf16_t* pa = P + (r0 - 2) * NP + c8; const bf16_t* pb = P + (r0 - 1) * NP + c8;
            const u32x4 ca = *(const u32x4*)(pa + PC_C), va = *(const u32x4*)(pa + PC_VC), cb = *(const u32x4*)(pb + PC_C), vb = *(const u32x4*)(pb + PC_VC);
#pragma unroll
            for (int e = 0; e < 4; ++e) { z2[2 * e] = bflo(ca[e]) * bflo(va[e]); z2[2 * e + 1] = bfhi(ca[e]) * bfhi(va[e]); z1[2 * e] = bflo(cb[e]) * bflo(vb[e]); z1[2 * e + 1] = bfhi(cb[e]) * bfhi(vb[e]); }
        }
#pragma unroll 4
        for (int rr = 0; rr < 16; ++rr) {
            bf16_t* pr = P + (r0 + rr) * NP + c8;
            const u32x4 cc = *(const u32x4*)(pr + PC_C), vv = *(const u32x4*)(pr + PC_VC), bb = *(const u32x4*)(pr + PC_B);
            float z0[8], y[8];
#pragma unroll
            for (int e = 0; e < 4; ++e) { z0[2 * e] = bflo(cc[e]) * bflo(vv[e]); z0[2 * e + 1] = bfhi(cc[e]) * bfhi(vv[e]); }
#pragma unroll
            for (int e = 0; e < 8; ++e) y[e] = w0[e] * z2[e] + w1[e] * z1[e] + w2[e] * z0[e];
            u32x4 o;
#pragma unroll
            for (int e = 0; e < 4; ++e) o[e] = cvtpk(bflo(bb[e]) * y[2 * e], bfhi(bb[e]) * y[2 * e + 1]);
            *(u32x4*)(pr + PC_B) = o;
#pragma unroll
            for (int e = 0; e < 8; ++e) { z2[e] = z1[e]; z1[e] = z0[e]; }
        }
    }
}

struct Args { const float* in[20]; float* out; unsigned char* ws; int ph_lo, ph_hi; };
enum { I_X = 0, I_N1, I_WG1, I_WU1, I_WD1, I_NM, I_WIN, I_CONVW, I_QN, I_KN, I_SINK, I_WCO, I_WAO, I_WBG, I_BBG, I_WOUT, I_N2, I_WG2, I_WU2, I_WD2 };

__global__ void __launch_bounds__(512, 2) fwd(Args a) {
    extern __shared__ __attribute__((aligned(16))) unsigned char lds_raw[];
    LAS unsigned char* lds = (LAS unsigned char*)lds_raw;
    const int tid = threadIdx.x, lane = tid & 63, wave = __builtin_amdgcn_readfirstlane(tid >> 6);
    const int G = gridDim.x, bx = blockIdx.x;
    const int vcu = (G % 8 == 0) ? (bx % 8) * (G / 8) + bx / 8 : bx;
    unsigned char* ws = a.ws;
    bf16_t* W1 = (bf16_t*)(ws + WS_W1); bf16_t* W2 = (bf16_t*)(ws + WS_W2); bf16_t* W3 = (bf16_t*)(ws + WS_W3); bf16_t* W4 = (bf16_t*)(ws + WS_W4);
    bf16_t* W5 = (bf16_t*)(ws + WS_W5); bf16_t* W6 = (bf16_t*)(ws + WS_W6); bf16_t* W7 = (bf16_t*)(ws + WS_W7);
    float* PART1 = (float*)(ws + WS_PART1); float* PART2 = (float*)(ws + WS_PART2);
    bf16_t* XN = (bf16_t*)(ws + WS_XN); bf16_t* P = (bf16_t*)(ws + WS_P); bf16_t* X2G = (bf16_t*)(ws + WS_X2G); bf16_t* HB = (bf16_t*)(ws + WS_H);
    const int lo = a.ph_lo, hi = a.ph_hi;
#ifndef PH_MASK
#define PH_MASK 0x1ff
#endif
#define IN(k) (((PH_MASK >> (k)) & 1) && lo <= (k) && (k) < hi)
#if MK_N_LAUNCHES == 1
#define SEAM(k) do { if (IN(k) && IN((k) + 1)) cg::this_grid().sync(); } while (0)
#else
#define SEAM(k) do { } while (0)
#endif

    if (IN(0)) {
        LAS float* scr = (LAS float*)(lds + wave * 16384);
        const int gw = vcu * 8 + wave, NGW = G * 8;
        constexpr int NB_FF = FF / 32, IT_GU = 16 * NB_FF, IT_DN = (FF / 64) * 32, IT_IN = 16 * 136, IT_BG = 16 * 64, IT_SQ = 16 * 32;
        constexpr int NITEMS = 4 * IT_GU + 2 * IT_DN + IT_IN + IT_BG + 3 * IT_SQ;
        for (int it = gw; it < NITEMS; it += NGW) {
            int r = it;
            if (r < 4 * IT_GU) {
                const int which = r / IT_GU; r -= which * IT_GU; const int kb = r / NB_FF, nb = r % NB_FF, n0 = nb * 32;
                const float* W = a.in[which == 0 ? I_WG1 : which == 1 ? I_WU1 : which == 2 ? I_WG2 : I_WU2];
                p0_transpose_item(W, FF, (which < 2) ? W1 : W6, D, 0, 256 * (n0 >> 7) + 128 * (which & 1) + (n0 & 127), kb * 64, n0, scr, lane, (which < 2) ? nullptr : a.in[I_N2]); continue; }
            r -= 4 * IT_GU;
            if (r < 2 * IT_DN) { const int which = r / IT_DN; r -= which * IT_DN; const int kb = r / 32, nb = r % 32;
                p0_transpose_item(a.in[which ? I_WD2 : I_WD1], D, which ? W7 : W2, FF, 0, nb * 32, kb * 64, nb * 32, scr, lane); continue; }
            r -= 2 * IT_DN;
            if (r < IT_IN) { const int kb = r / 136, nb = r % 136, n0 = nb * 32;
                const int dr = n0 < 1024 ? n0 + 2048 : (n0 < 3072 ? n0 - 1024 : n0);
                p0_transpose_item(a.in[I_WIN], 4352, W3, D, 0, dr, kb * 64, n0, scr, lane, a.in[I_NM]); continue; }
            r -= IT_IN;
            if (r < IT_BG) { const int kb = r / 64, nb = r % 64; p0_transpose_item(a.in[I_WBG], 2048, W3, D, 0, PC_GC + nb * 32, kb * 64, nb * 32, scr, lane, a.in[I_NM]); continue; }
            r -= IT_BG;
            { const int which = r / IT_SQ; r -= which * IT_SQ; const int kb = r / 32, nb = r % 32;
              if (which == 0) p0_transpose_item(a.in[I_WCO], D, W4, 2048, 0, nb * 32, kb * 64, nb * 32, scr, lane);
              else if (which == 1) p0_transpose_item(a.in[I_WAO], D, W4, 2048, 1024, nb * 32, kb * 64, nb * 32, scr, lane);
              else p0_transpose_item(a.in[I_WOUT], D, W5, D, 0, nb * 32, kb * 64, nb * 32, scr, lane); }
        }
        const float* x = a.in[I_X]; const float* g1 = a.in[I_N1];
        f32x4 gv[4];
#pragma unroll
        for (int j = 0; j < 4; ++j) gv[j] = ((const f32x4*)g1)[64 * j + lane];
        for (int m = gw; m < M; m += NGW) {
            const f32x4* xr = (const f32x4*)(x + (size_t)m * D) + lane;
            f32x4 v[4]; float s = 0.f;
#pragma unroll
            for (int j = 0; j < 4; ++j) { v[j] = xr[64 * j]; s += (v[j].x * v[j].x + v[j].y * v[j].y) + (v[j].z * v[j].z + v[j].w * v[j].w); }
            const float rstd = rsqrtf(wave_sum(s) * (1.f / D) + EPS);
            u32x2* o8 = (u32x2*)(XN + (size_t)m * D) + lane;
#pragma unroll
            for (int j = 0; j < 4; ++j) { u32x2 o; o.x = cvtpk(v[j].x * rstd * gv[j].x, v[j].y * rstd * gv[j].y); o.y = cvtpk(v[j].z * rstd * gv[j].z, v[j].w * rstd * gv[j].w); o8[64 * j] = o; }
        }
        asm volatile("s_waitcnt vmcnt(0) lgkmcnt(0)" ::: "memory"); __syncthreads();
    }
    SEAM(0);
    if (IN(1)) { pg8::Gemm g{XN, W1, D, 2 * FF, D}; pg8::StaticOrder S; S.init(M, 2 * FF, G, bx); pg8::EpiSwiglu E{HB, nullptr}; pg8::gemm_phase(lds, g, S, E); }
    SEAM(1);
    LAS float* red = (LAS float*)(lds + RING_BYTES);
    if (IN(2)) { pg8::Gemm g{HB, W2, FF, D, FF}; pg8::StaticOrder S; S.init(M, D, G, bx); pg8::EpiResid<0> E{a.in[I_X], nullptr, nullptr, XN, 0.5f, PART1, red}; pg8::gemm_phase(lds, g, S, E); }
    SEAM(2);
    if (IN(3)) { pg8::Gemm g{XN, W3, D, NP, D}; pg8::StaticOrder S; S.init(M, NP, G, bx); pg8::EpiProj E{P, PART1, a.in[I_BBG]}; pg8::gemm_phase(lds, g, S, E); }
    SEAM(3);
    if (IN(4)) {
        conv_pass(P, a.in[I_CONVW], vcu * 512 + tid, G * 512);
        for (int unit = vcu; unit < 1024; unit += G) att::attn_unit(lds, P, a.in[I_QN], a.in[I_KN], a.in[I_SINK], unit, tid, wave, lane);
        asm volatile("s_waitcnt vmcnt(0) lgkmcnt(0)" ::: "memory"); __syncthreads();
    }
    SEAM(4);
    bf16_t* MG = (bf16_t*)a.out;
    if (IN(5)) { pg8::Gemm g{P + PC_B, W4, NP, D, 2048}; pg8::StaticOrder S; S.init(M, D, G, bx); pg8::EpiMix E{P, MG}; pg8::gemm_phase(lds, g, S, E); }
    SEAM(5);
    if (IN(6)) { pg8::Gemm g{MG, W5, D, D, D}; pg8::StaticOrder S; S.init(M, D, G, bx); pg8::EpiResid<1> E{nullptr, XN, nullptr, X2G, 1.0f, PART2, red}; pg8::gemm_phase(lds, g, S, E); }
    SEAM(6);
    if (IN(7)) { pg8::Gemm g{X2G, W6, D, 2 * FF, D}; pg8::StaticOrder S; S.init(M, 2 * FF, G, bx); pg8::EpiSwiglu E{HB, PART2}; pg8::gemm_phase(lds, g, S, E); }
    SEAM(7);
    if (IN(8)) { pg8::Gemm g{HB, W7, FF, D, FF}; pg8::StaticOrder S; S.init(M, D, G, bx); pg8::EpiResid<2> E{nullptr, X2G, a.out, nullptr, 0.5f, nullptr, red}; pg8::gemm_phase(lds, g, S, E); }
#undef IN
#undef SEAM
}

extern "C" void kernel_launch(void* const* d_in, const int* in_sizes, int n_in, void* d_out, int out_size, void* d_ws, size_t ws_size, hipStream_t stream) {
    static int grid = 0;
    if (grid == 0) {
        if (n_in != 20 || in_sizes[0] != M * D || out_size != M * D || ws_size < WS_END) { fprintf(stderr, "kernel_launch: unexpected shapes (n_in %d, in0 %d, out %d, ws %zu < %zu)\n", n_in, n_in > 0 ? in_sizes[0] : -1, out_size, ws_size, (size_t)WS_END); grid = -1; return; }
        int dev = 0, cus = 0, per_cu = 0;
        hipGetDevice(&dev); hipDeviceGetAttribute(&cus, hipDeviceAttributeMultiprocessorCount, dev);
        if (hipFuncSetAttribute((const void*)fwd, hipFuncAttributeMaxDynamicSharedMemorySize, LDS_BYTES) != hipSuccess) { fprintf(stderr, "kernel_launch: hipFuncSetAttribute failed\n"); grid = -1; return; }
        hipOccupancyMaxActiveBlocksPerMultiprocessor(&per_cu, (const void*)fwd, 512, LDS_BYTES);
        (void)hipGetLastError();
        if (per_cu < 1) per_cu = 1;
        grid = cus * 1;
        fprintf(stderr, "kernel_launch: cus %d per_cu %d grid %d\n", cus, per_cu, grid);
    }
    if (grid < 0) return;
    Args a{};
    for (int i = 0; i < 20; ++i) a.in[i] = (const float*)d_in[i];
    a.out = (float*)d_out; a.ws = (unsigned char*)d_ws;
#if MK_N_LAUNCHES == 1
    a.ph_lo = 0; a.ph_hi = 9;
    void* args[] = {&a};
    hipError_t e = hipLaunchCooperativeKernel((const void*)fwd, dim3(grid), dim3(512), args, LDS_BYTES, stream);
    if (e != hipSuccess) fprintf(stderr, "cooperative launch failed: %s (grid %d)\n", hipGetErrorString(e), grid);
#else
    for (int p = 0; p < 9; ++p) { a.ph_lo = p; a.ph_hi = p + 1; hipLaunchKernelGGL(fwd, dim3(grid), dim3(512), LDS_BYTES, stream, a); }
#endif
}
```

```cpp
#include <hip/hip_runtime.h>
#include <hip/hip_cooperative_groups.h>
#include <cstdio>
#include <cstdint>
namespace cg = cooperative_groups;

#ifndef MK_N_LAUNCHES
#define MK_N_LAUNCHES 1
#endif

#define LAS __attribute__((address_space(3)))
typedef unsigned short bf16_t;
typedef short bf16x8 __attribute__((ext_vector_type(8)));
typedef float f32x4 __attribute__((ext_vector_type(4)));
typedef float f32x16 __attribute__((ext_vector_type(16)));
typedef unsigned u32x4 __attribute__((ext_vector_type(4)));
typedef unsigned u32x2 __attribute__((ext_vector_type(2)));
typedef float f32x2_t __attribute__((ext_vector_type(2)));
typedef __bf16 bf16x2_t __attribute__((ext_vector_type(2)));

constexpr int M = 65536, D = 1024, FF = 2816, SEQ = 2048;
constexpr int NP = 6400;
constexpr int PC_C = 0, PC_VC = 1024, PC_B = 2048, PC_Q = 3072, PC_K = 4096, PC_V = 4224, PC_GC = 4352, PC_GA = 5376;
constexpr float EPS = 1e-6f;
constexpr float LOG2E = 1.4426950408889634f;

constexpr size_t MiB = 1u << 20;
constexpr size_t WS_W1 = 0;
constexpr size_t WS_W2 = 11 * MiB;
constexpr size_t WS_W3 = 17 * MiB;
constexpr size_t WS_W4 = 30 * MiB;
constexpr size_t WS_W5 = 34 * MiB;
constexpr size_t WS_W6 = 36 * MiB;
constexpr size_t WS_W7 = 47 * MiB;
constexpr size_t WS_PART1 = 53 * MiB;
constexpr size_t WS_PART2 = 57 * MiB;
constexpr size_t WS_XN = 64 * MiB;
constexpr size_t WS_P = 192 * MiB;
constexpr size_t WS_X2G = WS_P;
constexpr size_t WS_H = WS_P + 128 * MiB;
constexpr size_t WS_END = WS_P + 800 * MiB;

constexpr int RING_BYTES = 131072;
constexpr int LDS_BYTES = 147456;

__device__ __forceinline__ unsigned cvtpk(float lo, float hi) { f32x2_t v = {lo, hi}; bf16x2_t b = __builtin_convertvector(v, bf16x2_t); return __builtin_bit_cast(unsigned, b); }
__device__ __forceinline__ float bflo(unsigned w) { return __uint_as_float(w << 16); }
__device__ __forceinline__ float bfhi(unsigned w) { return __uint_as_float(w & 0xffff0000u); }
__device__ __forceinline__ float sigmoidf_(float z) { return __builtin_amdgcn_rcpf(1.f + __expf(-z)); }
__device__ __forceinline__ float rstd_from_parts(const float* p) {
    const f32x4 a = *(const f32x4*)p;
    return rsqrtf(((a.x + a.y) + (a.z + a.w)) * (1.0f / 1024.0f) + EPS);
}

namespace pg8 {
constexpr int BM = 256, BK = 64, HALF = 128, HTB = HALF * BK * 2, STAGE_BYTES = 8 * HTB, NXCD = 8, WGM = 8;
__host__ __device__ __forceinline__ int lds_byte(int r, int c) { const int st = (r >> 4) * 2 + (c >> 5), rr = r & 15, cc = c & 31, ob = rr * 64 + cc * 2; return st * 1024 + (ob ^ (((ob >> 9) & 1) << 5)); }
__host__ __device__ __forceinline__ void stage_rc(int b, int& R, int& C) { const int st = b / 1024, sb = b % 1024, swz = sb ^ (((sb >> 9) & 1) << 5); R = (st >> 1) * 16 + swz / 64; C = (st & 1) * 32 + (swz % 64) / 2; }
__host__ __device__ __forceinline__ int perm32(int rho) { const int n = rho >> 4, i = rho & 15; return 8 * (i >> 2) + 4 * n + (i & 3); }

struct Unit { int pm, pn; };
struct Gemm { const bf16_t* A; const bf16_t* Bt; int lda, N, K; };

struct StaticOrder {
    int nM, nN, nwg, G, c;
    __device__ void init(int Mr, int N, int G_, int c_) { nM = Mr / BM; nN = N / BM; nwg = nM * nN; G = G_; c = c_; }
    __device__ bool next(int i, Unit& u) const {
        const long L = (long)i * G + c; if (L >= nwg) return false;
        int wgid = (int)L; { const int q = nwg / NXCD, r = nwg % NXCD, xcd = wgid % NXCD, off = wgid / NXCD; wgid = (xcd < r ? xcd * (q + 1) : r * (q + 1) + (xcd - r) * q) + off; }
        const int nig = WGM * nN, gid = wgid / nig, fm = gid * WGM, gsz = (nM - fm) < WGM ? (nM - fm) : WGM;
        u.pm = fm + ((wgid % nig) % gsz); u.pn = (wgid % nig) / gsz; return true;
    }
};

typedef f32x4 Acc[2][2][4][2];

struct EpiSwiglu {
    static constexpr bool HAS_MID = false; static constexpr int MID_T = -1;
    bf16_t* H; const float* part;
    __device__ __forceinline__ void mid(Acc&, const Unit&, int, int, int, int) const {}
    __device__ __forceinline__ void operator()(const Acc& acc, const Unit& u, int wr, int wc, int fr, int fq) const {
        const int row0 = u.pm * BM + wr * 64 + fr, col0 = u.pn * HALF + wc * 32 + 8 * fq;
#pragma unroll
        for (int ai = 0; ai < 2; ++ai)
#pragma unroll
            for (int m = 0; m < 4; ++m) {
                const int row = row0 + ai * HALF + m * 16;
                const float rs = part ? rstd_from_parts(part + (size_t)row * 4) : 1.0f;
                float h[8];
#pragma unroll
                for (int n = 0; n < 2; ++n)
#pragma unroll
                    for (int i = 0; i < 4; ++i) { const float g = acc[ai][0][m][n][i] * rs, up = acc[ai][1][m][n][i] * rs; h[4 * n + i] = g * sigmoidf_(g) * up; }
                u32x4 w; w.x = cvtpk(h[0], h[1]); w.y = cvtpk(h[2], h[3]); w.z = cvtpk(h[4], h[5]); w.w = cvtpk(h[6], h[7]);
                *(u32x4*)(H + (size_t)row * FF + col0) = w;
            }
    }
};

template <int MODE> struct EpiResid {
    static constexpr bool HAS_MID = false; static constexpr int MID_T = -1;
    const float* basef; const bf16_t* baseb; float* outf; bf16_t* outb; float alpha; float* part; LAS float* red;
    __device__ __forceinline__ void mid(Acc&, const Unit&, int, int, int, int) const {}
    __device__ __forceinline__ void operator()(const Acc& acc, const Unit& u, int wr, int wc, int fr, int fq) const {
        const int row0 = u.pm * BM + wr * 64 + fr, col0 = u.pn * BM + wc * 32 + 8 * fq;
#pragma unroll
        for (int ai = 0; ai < 2; ++ai)
#pragma unroll
            for (int m = 0; m < 4; ++m) {
                const int row = row0 + ai * HALF + m * 16; float ss = 0.f;
#pragma unroll
                for (int bj = 0; bj < 2; ++bj) {
                    const size_t off = (size_t)row * D + col0 + bj * HALF;
                    f32x4 b0, b1;
                    if (MODE == 0) { b0 = *(const f32x4*)(basef + off); b1 = *(const f32x4*)(basef + off + 4); }
                    else { const u32x4 w = *(const u32x4*)(baseb + off); b0 = (f32x4){bflo(w.x), bfhi(w.x), bflo(w.y), bfhi(w.y)}; b1 = (f32x4){bflo(w.z), bfhi(w.z), bflo(w.w), bfhi(w.w)}; }
                    const f32x4 v0 = b0 + acc[ai][bj][m][0] * alpha, v1 = b1 + acc[ai][bj][m][1] * alpha;
                    if (MODE == 2) { *(f32x4*)(outf + off) = v0; *(f32x4*)(outf + off + 4) = v1; }
                    else {
                        ss += (v0.x * v0.x + v0.y * v0.y) + (v0.z * v0.z + v0.w * v0.w) + (v1.x * v1.x + v1.y * v1.y) + (v1.z * v1.z + v1.w * v1.w);
                        u32x4 w; w.x = cvtpk(v0.x, v0.y); w.y = cvtpk(v0.z, v0.w); w.z = cvtpk(v1.x, v1.y); w.w = cvtpk(v1.z, v1.w); *(u32x4*)(outb + off) = w;
                    }
                }
                if (MODE != 2) { ss += __shfl_xor(ss, 16); ss += __shfl_xor(ss, 32); if (fq == 0) red[(ai * HALF + wr * 64 + m * 16 + fr) * 4 + wc] = ss; }
            }
        if (MODE != 2) {
            asm volatile("s_waitcnt lgkmcnt(0)" ::: "memory"); __builtin_amdgcn_s_barrier(); asm volatile("" ::: "memory");
            const int t = threadIdx.x;
            if (t < 256) { const f32x4 r = *(const LAS f32x4*)(red + t * 4); part[(size_t)(u.pm * BM + t) * 4 + u.pn] = (r.x + r.y) + (r.z + r.w); }
            asm volatile("s_waitcnt lgkmcnt(0)" ::: "memory"); __builtin_amdgcn_s_barrier(); asm volatile("" ::: "memory");
        }
    }
};

struct EpiProj {
    static constexpr bool HAS_MID = false; static constexpr int MID_T = -1;
    bf16_t* P; const float* part; const float* bias;
    __device__ __forceinline__ void mid(Acc&, const Unit&, int, int, int, int) const {}
    __device__ __forceinline__ void operator()(const Acc& acc, const Unit& u, int wr, int wc, int fr, int fq) const {
        const int row0 = u.pm * BM + wr * 64 + fr, col0 = u.pn * BM + wc * 32 + 8 * fq; const bool gate = u.pn >= 17;
        f32x4 bv[2][2];
#pragma unroll
        for (int bj = 0; bj < 2; ++bj)
#pragma unroll
            for (int n = 0; n < 2; ++n) bv[bj][n] = gate ? *(const f32x4*)(bias + (col0 - PC_GC) + bj * HALF + 4 * n) : (f32x4){0.f, 0.f, 0.f, 0.f};
#pragma unroll
        for (int ai = 0; ai < 2; ++ai)
#pragma unroll
            for (int m = 0; m < 4; ++m) {
                const int row = row0 + ai * HALF + m * 16; const float rs = rstd_from_parts(part + (size_t)row * 4);
#pragma unroll
                for (int bj = 0; bj < 2; ++bj) {
                    f32x4 v0 = acc[ai][bj][m][0] * rs + bv[bj][0], v1 = acc[ai][bj][m][1] * rs + bv[bj][1];
                    if (gate) { v0.x = sigmoidf_(v0.x); v0.y = sigmoidf_(v0.y); v0.z = sigmoidf_(v0.z); v0.w = sigmoidf_(v0.w); v1.x = sigmoidf_(v1.x); v1.y = sigmoidf_(v1.y); v1.z = sigmoidf_(v1.z); v1.w = sigmoidf_(v1.w); }
                    u32x4 w; w.x = cvtpk(v0.x, v0.y); w.y = cvtpk(v0.z, v0.w); w.z = cvtpk(v1.x, v1.y); w.w = cvtpk(v1.z, v1.w);
                    *(u32x4*)(P + (size_t)row * NP + col0 + bj * HALF) = w;
                }
            }
    }
};

struct EpiMix {
    static constexpr bool HAS_MID = true; static constexpr int MID_T = 16;
    const bf16_t* P; bf16_t* out;
    __device__ __forceinline__ void mid(Acc& acc, const Unit& u, int wr, int wc, int fr, int fq) const {
        int row0 = u.pm * BM + wr * 64 + fr; const int col0 = u.pn * BM + wc * 32 + 8 * fq;
        asm volatile("" : "+v"(row0));
#pragma unroll
        for (int ai = 0; ai < 2; ++ai)
#pragma unroll
            for (int m = 0; m < 4; ++m) {
                const int row = row0 + ai * HALF + m * 16;
#pragma unroll
                for (int bj = 0; bj < 2; ++bj) {
                    const bf16_t* pr = P + (size_t)row * NP + col0 + bj * HALF;
                    const u32x4 gc = *(const u32x4*)(pr + PC_GC), ga = *(const u32x4*)(pr + PC_GA);
                    f32x4 r0, r1;
                    r0.x = bflo(gc.x) * __builtin_amdgcn_rcpf(fmaxf(bflo(ga.x), 1e-30f)); r0.y = bfhi(gc.x) * __builtin_amdgcn_rcpf(fmaxf(bfhi(ga.x), 1e-30f));
                    r0.z = bflo(gc.y) * __builtin_amdgcn_rcpf(fmaxf(bflo(ga.y), 1e-30f)); r0.w = bfhi(gc.y) * __builtin_amdgcn_rcpf(fmaxf(bfhi(ga.y), 1e-30f));
                    r1.x = bflo(gc.z) * __builtin_amdgcn_rcpf(fmaxf(bflo(ga.z), 1e-30f)); r1.y = bfhi(gc.z) * __builtin_amdgcn_rcpf(fmaxf(bfhi(ga.z), 1e-30f));
                    r1.z = bflo(gc.w) * __builtin_amdgcn_rcpf(fmaxf(bflo(ga.w), 1e-30f)); r1.w = bfhi(gc.w) * __builtin_amdgcn_rcpf(fmaxf(bfhi(ga.w), 1e-30f));
                    acc[ai][bj][m][0] *= r0; acc[ai][bj][m][1] *= r1;
                }
                if (m & 1) asm volatile("" ::: "memory");
            }
    }
    __device__ __forceinline__ void operator()(const Acc& acc, const Unit& u, int wr, int wc, int fr, int fq) const {
        const int row0 = u.pm * BM + wr * 64 + fr, col0 = u.pn * BM + wc * 32 + 8 * fq;
#pragma unroll
        for (int ai = 0; ai < 2; ++ai)
#pragma unroll
            for (int m = 0; m < 4; ++m) {
                const int row = row0 + ai * HALF + m * 16;
#pragma unroll
                for (int bj = 0; bj < 2; ++bj) {
                    const u32x4 ga = *(const u32x4*)(P + (size_t)row * NP + col0 + bj * HALF + PC_GA);
                    f32x4 g0, g1;
                    g0.x = fmaxf(bflo(ga.x), 1e-30f); g0.y = fmaxf(bfhi(ga.x), 1e-30f); g0.z = fmaxf(bflo(ga.y), 1e-30f); g0.w = fmaxf(bfhi(ga.y), 1e-30f);
                    g1.x = fmaxf(bflo(ga.z), 1e-30f); g1.y = fmaxf(bfhi(ga.z), 1e-30f); g1.z = fmaxf(bflo(ga.w), 1e-30f); g1.w = fmaxf(bfhi(ga.w), 1e-30f);
                    const f32x4 v0 = acc[ai][bj][m][0] * g0, v1 = acc[ai][bj][m][1] * g1;
                    u32x4 w; w.x = cvtpk(v0.x, v0.y); w.y = cvtpk(v0.z, v0.w); w.z = cvtpk(v1.x, v1.y); w.w = cvtpk(v1.z, v1.w);
                    *(u32x4*)(out + (size_t)row * D + col0 + bj * HALF) = w;
                }
            }
    }
};

template <class Epi>
__device__ __forceinline__ void gemm_phase(LAS unsigned char* lds, const Gemm g, const StaticOrder& S, const Epi& E) {
    const int tid = threadIdx.x, wid = __builtin_amdgcn_readfirstlane(tid >> 6), lane = tid & 63, wr = wid >> 2, wc = wid & 3, fr = lane & 15, fq = lane >> 4;
    const int K = g.K, nt = K / BK, lda = g.lda;
    unsigned voffA[2], voffB[2];
#pragma unroll
    for (int i = 0; i < 2; ++i) { int R, C; stage_rc(tid * 16 + i * 8192, R, C); const int Rb = (R & ~31) + perm32(R & 31);
        voffA[i] = (unsigned)(R * lda + C) * 2u; voffB[i] = (unsigned)(Rb * K + C) * 2u; }
    const size_t kstep = (size_t)(BK * 2);
    const size_t hstepA = (size_t)HALF * lda * 2, hstepB = (size_t)HALF * K * 2;
    const size_t tstepA = 2 * hstepA, tstepB = 2 * hstepB;
    const unsigned ldsw = (unsigned)wid * 1024u;
    const int aoff = lds_byte(wr * 64 + fr, fq * 8), boff = lds_byte(wc * 32 + fr, fq * 8);
#define PG8_SA(b, h) (((b) * 2 + (h)) * HTB)
#define PG8_SB(b, h) ((4 + (b) * 2 + (h)) * HTB)
#define PG8_STAGE(bufoff, gbase, voff) do { _Pragma("unroll") for (int _i = 0; _i < 2; ++_i) \
        __builtin_amdgcn_global_load_lds((const unsigned*)((const char*)(gbase) + (voff)[_i]), (LAS unsigned*)(lds + (bufoff) + ldsw + _i * 8192), 16, 0, 0); } while (0)
#define PG8_LDA(dst, b, h) do { _Pragma("unroll") for (int m = 0; m < 4; ++m) _Pragma("unroll") for (int k = 0; k < 2; ++k) dst[m][k] = *(const LAS bf16x8*)(lds + PG8_SA(b, h) + aoff + m * 2048 + k * 1024); } while (0)
#define PG8_LDB(dst, b, h) do { _Pragma("unroll") for (int n = 0; n < 2; ++n) _Pragma("unroll") for (int k = 0; k < 2; ++k) dst[n][k] = *(const LAS bf16x8*)(lds + PG8_SB(b, h) + boff + n * 2048 + k * 1024); } while (0)
#define PG8_MMA(ai, bj, At, Bt) do { __builtin_amdgcn_s_setprio(1); _Pragma("unroll") for (int m = 0; m < 4; ++m) _Pragma("unroll") for (int n = 0; n < 2; ++n) _Pragma("unroll") for (int k = 0; k < 2; ++k) \
        acc[ai][bj][m][n] = __builtin_amdgcn_mfma_f32_16x16x32_bf16(Bt[n][k], At[m][k], acc[ai][bj][m][n], 0, 0, 0); __builtin_amdgcn_s_setprio(0); } while (0)
#define PG8_WAIT_V(n) asm volatile("s_waitcnt vmcnt(" #n ")" ::: "memory")
#define PG8_WAIT_L(n) asm volatile("s_waitcnt lgkmcnt(" #n ")" ::: "memory")
#define PG8_BAR __builtin_amdgcn_s_barrier()
#define PG8_SCHED __builtin_amdgcn_sched_barrier(0)
    Unit cur, nxt; int ui = 0;
    if (!S.next(0, cur)) return;
    Acc acc;
#pragma unroll
    for (int a = 0; a < 2; ++a)
#pragma unroll
        for (int b = 0; b < 2; ++b)
#pragma unroll
            for (int m = 0; m < 4; ++m)
#pragma unroll
                for (int n = 0; n < 2; ++n) acc[a][b][m][n] = (f32x4){0.f, 0.f, 0.f, 0.f};
    bf16x8 At[4][2], B0[2][2], B1[2][2];
    const char* cA = (const char*)g.A + (size_t)cur.pm * tstepA; const char* cB = (const char*)g.Bt + (size_t)cur.pn * tstepB;
    PG8_STAGE(PG8_SB(0, 0), cB, voffB); PG8_STAGE(PG8_SB(0, 1), cB + hstepB, voffB); PG8_STAGE(PG8_SA(0, 0), cA, voffA); PG8_STAGE(PG8_SA(0, 1), cA + hstepA, voffA);
    if (wr == 1) PG8_BAR;
    PG8_WAIT_V(2); PG8_BAR;
    PG8_STAGE(PG8_SB(1, 0), cB + kstep, voffB); PG8_STAGE(PG8_SA(1, 0), cA + kstep, voffA); PG8_STAGE(PG8_SB(1, 1), cB + hstepB + kstep, voffB);
    PG8_WAIT_V(6); PG8_BAR;
    for (;;) {
        const bool has_next = S.next(ui + 1, nxt);
        const char* nA = has_next ? (const char*)g.A + (size_t)nxt.pm * tstepA : cA; const char* nB = has_next ? (const char*)g.Bt + (size_t)nxt.pn * tstepB : cB;
        for (int t = 0; t < nt; t += 2) {
            if constexpr (Epi::HAS_MID) { if (t == Epi::MID_T) { E.mid(acc, cur, wr, wc, fr, fq); PG8_SCHED; } }
            const bool last = (t == nt - 2);
            const char* a1 = cA + (size_t)(t + 1) * kstep;
            const char* a2 = last ? nA : cA + (size_t)(t + 2) * kstep; const char* b2 = last ? nB : cB + (size_t)(t + 2) * kstep;
            const char* a3 = a2 + kstep; const char* b3 = b2 + kstep;
            PG8_LDB(B0, 0, 0); PG8_LDB(B1, 0, 1); PG8_SCHED; PG8_LDA(At, 0, 0); PG8_STAGE(PG8_SA(1, 1), a1 + hstepA, voffA);
            PG8_WAIT_V(8); PG8_WAIT_L(0); PG8_BAR; PG8_MMA(0, 0, At, B0); PG8_MMA(0, 1, At, B1); PG8_BAR; PG8_SCHED;
            PG8_LDA(At, 0, 1); PG8_STAGE(PG8_SB(0, 0), b2, voffB); PG8_STAGE(PG8_SB(0, 1), b2 + hstepB, voffB); PG8_STAGE(PG8_SA(0, 0), a2, voffA);
            PG8_WAIT_V(8); PG8_WAIT_L(0); PG8_BAR; PG8_MMA(1, 0, At, B0); PG8_MMA(1, 1, At, B1); PG8_BAR; PG8_SCHED;
            PG8_LDB(B0, 1, 0); PG8_LDB(B1, 1, 1); PG8_SCHED; PG8_LDA(At, 1, 0); PG8_STAGE(PG8_SA(0, 1), a2 + hstepA, voffA);
            PG8_WAIT_V(8); PG8_WAIT_L(0); PG8_BAR; PG8_MMA(0, 0, At, B0); PG8_MMA(0, 1, At, B1); PG8_BAR; PG8_SCHED;
            PG8_LDA(At, 1, 1); PG8_STAGE(PG8_SB(1, 0), b3, voffB); PG8_STAGE(PG8_SB(1, 1), b3 + hstepB, voffB); PG8_STAGE(PG8_SA(1, 0), a3, voffA);
            PG8_WAIT_V(8); PG8_WAIT_L(0); PG8_BAR; PG8_MMA(1, 0, At, B0); PG8_MMA(1, 1, At, B1); PG8_BAR; PG8_SCHED;
        }
        if (wr == 0) PG8_BAR;
        E(acc, cur, wr, wc, fr, fq);
        if (!has_next) break;
#pragma unroll
        for (int a = 0; a < 2; ++a)
#pragma unroll
            for (int b = 0; b < 2; ++b)
#pragma unroll
                for (int m = 0; m < 4; ++m)
#pragma unroll
                    for (int n = 0; n < 2; ++n) acc[a][b][m][n] = (f32x4){0.f, 0.f, 0.f, 0.f};
        cur = nxt; cA = nA; cB = nB; ++ui;
        if (wr == 1) PG8_BAR;
    }
    PG8_WAIT_V(0);
    PG8_BAR;
#undef PG8_SA
#undef PG8_SB
#undef PG8_STAGE
#undef PG8_LDA
#undef PG8_LDB
#undef PG8_MMA
#undef PG8_WAIT_V
#undef PG8_WAIT_L
#undef PG8_BAR
#undef PG8_SCHED
}
}

__device__ __forceinline__ float wave_sum(float v) {
#pragma unroll
    for (int o = 1; o < 64; o <<= 1) v += __shfl_xor(v, o);
    return v;
}
__device__ __forceinline__ void p0_transpose_item(const float* W, int N, bf16_t* WT, int ldk, int koff, int drow0, int k0, int n0, LAS float* scr, int lane, const float* ksc = nullptr) {
#pragma unroll 8
    for (int i = 0; i < 32; ++i) { const int kk = 2 * i + (lane >> 5); const float sc = ksc ? ksc[k0 + kk] : 1.0f; scr[kk * 33 + (lane & 31)] = W[(size_t)(k0 + kk) * N + n0 + (lane & 31)] * sc; }
    asm volatile("s_waitcnt lgkmcnt(0)" ::: "memory");
    const int c = lane & 7;
#pragma unroll
    for (int j = 0; j < 4; ++j) { const int n = (lane >> 3) + 8 * j; const LAS float* s = scr + (8 * c) * 33 + n;
        u32x4 o; o.x = cvtpk(s[0 * 33], s[1 * 33]); o.y = cvtpk(s[2 * 33], s[3 * 33]); o.z = cvtpk(s[4 * 33], s[5 * 33]); o.w = cvtpk(s[6 * 33], s[7 * 33]);
        *(u32x4*)(WT + (size_t)(drow0 + n) * ldk + koff + k0 + 8 * c) = o; }
    asm volatile("s_waitcnt lgkmcnt(0)" ::: "memory");
}

namespace att {
constexpr int KPB = 144;
constexpr int VP = 260;
constexpr int LDS_K = 0, LDS_V = 36864, LDS_WS = 70144, LDS_OST = 72192, LDS_END = 104960;
__device__ __forceinline__ int crow(int r, int hi) { return (r & 3) + 8 * (r >> 2) + 4 * hi; }

struct KVRegs { u32x4 kr[4], vr[4]; };
__device__ __forceinline__ void kv_load(KVRegs& R, const bf16_t* P, int unit, int tid) {
    const int hk = unit & 1, n = (unit >> 1) & 15, b = unit >> 5;
    const int kk = tid >> 1, half = tid & 1; const int kp = n * 128 - 128 + kk;
    if (kp >= 0) { const bf16_t* pr = P + ((size_t)b * SEQ + kp) * NP + PC_K + hk * 64 + half * 32;
#pragma unroll
        for (int i = 0; i < 4; ++i) { R.kr[i] = *(const u32x4*)(pr + 8 * i); R.vr[i] = *(const u32x4*)(pr + 128 + 8 * i); } }
    else {
#pragma unroll
        for (int i = 0; i < 4; ++i) { R.kr[i] = (u32x4){0u, 0u, 0u, 0u}; R.vr[i] = (u32x4){0u, 0u, 0u, 0u}; } }
}
__device__ __forceinline__ void kv_write(const KVRegs& R, LAS unsigned char* lds, const float* kn_w, int tid) {
    const int kk = tid >> 1, half = tid & 1;
    float ss = 0.f;
#pragma unroll
    for (int i = 0; i < 4; ++i)
#pragma unroll
        for (int e = 0; e < 4; ++e) { const float a = bflo(R.kr[i][e]), c = bfhi(R.kr[i][e]); ss += a * a + c * c; }
    ss += __shfl_xor(ss, 1);
    const float rs = rsqrtf(ss * (1.0f / 64.0f) + EPS);
#pragma unroll
    for (int i = 0; i < 4; ++i) {
        const f32x4 w0 = *(const f32x4*)(kn_w + half * 32 + 8 * i), w1 = *(const f32x4*)(kn_w + half * 32 + 8 * i + 4);
        u32x4 o;
        o.x = cvtpk(bflo(R.kr[i].x) * rs * w0.x, bfhi(R.kr[i].x) * rs * w0.y); o.y = cvtpk(bflo(R.kr[i].y) * rs * w0.z, bfhi(R.kr[i].y) * rs * w0.w);
        o.z = cvtpk(bflo(R.kr[i].z) * rs * w1.x, bfhi(R.kr[i].z) * rs * w1.y); o.w = cvtpk(bflo(R.kr[i].w) * rs * w1.z, bfhi(R.kr[i].w) * rs * w1.w);
        *(LAS u32x4*)(lds + LDS_K + kk * KPB + half * 64 + 16 * i) = o;
    }
#pragma unroll
    for (int i = 0; i < 4; ++i)
#pragma unroll
        for (int e = 0; e < 8; ++e) {
            const unsigned short val = (unsigned short)((R.vr[i][e >> 1] >> (16 * (e & 1))) & 0xffffu);
            *(LAS unsigned short*)(lds + LDS_V + ((half * 32 + 8 * i + e) * VP + kk) * 2) = val;
        }
}
__device__ __forceinline__ void attn_compute(LAS unsigned char* lds, bf16_t* P, const float* qn_w, const float* sinks, int unit, int wid, int lane) {
    const int hk = unit & 1, n = (unit >> 1) & 15, b = unit >> 5;
    const int T0 = n * 128; const size_t rowbase = (size_t)b * SEQ;
    const int h = hk * 8 + wid, r32 = lane & 31, hi = lane >> 5;
    const float sink2 = sinks[h] * LOG2E;
    LAS float* wsf = (LAS float*)(lds + LDS_WS) + wid * 64;
    LAS bf16_t* stg = (LAS bf16_t*)(lds + LDS_OST) + wid * 2048;
    const float NEG = -1e30f;
    u32x4 qnext[4];
    { const bf16_t* qp = P + (rowbase + T0 + r32) * NP + PC_Q + h * 64;
#pragma unroll
      for (int d0 = 0; d0 < 4; ++d0) qnext[d0] = *(const u32x4*)(qp + 16 * d0 + 8 * hi); }
#pragma unroll 1
    for (int j = 0; j < 4; ++j) {
        u32x4 qraw[4]; float ss = 0.f;
#pragma unroll
        for (int d0 = 0; d0 < 4; ++d0) { qraw[d0] = qnext[d0];
#pragma unroll
            for (int e = 0; e < 4; ++e) { const float a = bflo(qraw[d0][e]), c = bfhi(qraw[d0][e]); ss += a * a + c * c; } }
        if (j < 3) { const bf16_t* qp = P + (rowbase + T0 + 32 * (j + 1) + r32) * NP + PC_Q + h * 64;
#pragma unroll
            for (int d0 = 0; d0 < 4; ++d0) qnext[d0] = *(const u32x4*)(qp + 16 * d0 + 8 * hi); }
        ss += __shfl_xor(ss, 32);
        const float rs = rsqrtf(ss * (1.0f / 64.0f) + EPS) * (0.125f * LOG2E);
        bf16x8 qr[4];
#pragma unroll
        for (int d0 = 0; d0 < 4; ++d0) {
            const f32x4 w0 = *(const f32x4*)(qn_w + 16 * d0 + 8 * hi), w1 = *(const f32x4*)(qn_w + 16 * d0 + 8 * hi + 4);
            u32x4 o;
            o.x = cvtpk(bflo(qraw[d0].x) * rs * w0.x, bfhi(qraw[d0].x) * rs * w0.y); o.y = cvtpk(bflo(qraw[d0].y) * rs * w0.z, bfhi(qraw[d0].y) * rs * w0.w);
            o.z = cvtpk(bflo(qraw[d0].z) * rs * w1.x, bfhi(qraw[d0].z) * rs * w1.y); o.w = cvtpk(bflo(qraw[d0].w) * rs * w1.z, bfhi(qraw[d0].w) * rs * w1.w);
            qr[d0] = __builtin_bit_cast(bf16x8, o);
        }
        f32x16 S[5];
#pragma unroll
        for (int c = 0; c < 5; ++c) {
            f32x16 p;
#pragma unroll
            for (int r = 0; r < 16; ++r) p[r] = 0.f;
#pragma unroll
            for (int d0 = 0; d0 < 4; ++d0) {
                const bf16x8 kf = *(const LAS bf16x8*)(lds + LDS_K + (32 * (j + c) + r32) * KPB + (16 * d0 + 8 * hi) * 2);
                p = __builtin_amdgcn_mfma_f32_32x32x16_bf16(kf, qr[d0], p, 0, 0, 0);
            }
            S[c] = p;
        }
#pragma unroll
        for (int r = 0; r < 16; ++r) { const int kl = crow(r, hi); if (!(kl > r32)) S[0][r] = NEG; if (!(kl <= r32)) S[4][r] = NEG; }
        if (n == 0) {
#pragma unroll
            for (int c = 0; c < 5; ++c) if (j + c < 4) {
#pragma unroll
                for (int r = 0; r < 16; ++r) S[c][r] = NEG; }
        }
        float mx = sink2;
#pragma unroll
        for (int c = 0; c < 5; ++c)
#pragma unroll
            for (int r = 0; r < 16; ++r) mx = fmaxf(mx, S[c][r]);
        mx = fmaxf(mx, __shfl_xor(mx, 32));
        float l = 0.f;
#pragma unroll
        for (int c = 0; c < 5; ++c)
#pragma unroll
            for (int r = 0; r < 16; ++r) { const float p = __builtin_amdgcn_exp2f(S[c][r] - mx); S[c][r] = p; l += p; }
        l += __shfl_xor(l, 32);
        l += __builtin_amdgcn_exp2f(sink2 - mx);
        f32x16 o0, o1;
#pragma unroll
        for (int r = 0; r < 16; ++r) { o0[r] = 0.f; o1[r] = 0.f; }
#pragma unroll
        for (int c = 0; c < 5; ++c)
#pragma unroll
            for (int s = 0; s < 2; ++s) {
                u32x4 pw; pw.x = cvtpk(S[c][8 * s + 0], S[c][8 * s + 1]); pw.y = cvtpk(S[c][8 * s + 2], S[c][8 * s + 3]); pw.z = cvtpk(S[c][8 * s + 4], S[c][8 * s + 5]); pw.w = cvtpk(S[c][8 * s + 6], S[c][8 * s + 7]);
                const bf16x8 pa = __builtin_bit_cast(bf16x8, pw);
                const int kv0 = 32 * (j + c) + 16 * s + 4 * hi;
                { const LAS unsigned char* va = lds + LDS_V + (r32 * VP + kv0) * 2;
                  const u32x2 lo = *(const LAS u32x2*)va, hh = *(const LAS u32x2*)(va + 16);
                  const u32x4 vb = {lo.x, lo.y, hh.x, hh.y};
                  o0 = __builtin_amdgcn_mfma_f32_32x32x16_bf16(pa, __builtin_bit_cast(bf16x8, vb), o0, 0, 0, 0); }
                { const LAS unsigned char* va = lds + LDS_V + ((32 + r32) * VP + kv0) * 2;
                  const u32x2 lo = *(const LAS u32x2*)va, hh = *(const LAS u32x2*)(va + 16);
                  const u32x4 vb = {lo.x, lo.y, hh.x, hh.y};
                  o1 = __builtin_amdgcn_mfma_f32_32x32x16_bf16(pa, __builtin_bit_cast(bf16x8, vb), o1, 0, 0, 0); }
            }
        if (hi == 0) wsf[r32] = __builtin_amdgcn_rcpf(l);
        asm volatile("s_waitcnt lgkmcnt(0)" ::: "memory");
#pragma unroll
        for (int r = 0; r < 16; ++r) { const int orow = crow(r, hi); const float rl = wsf[orow];
            stg[orow * 64 + r32] = (bf16_t)(cvtpk(o0[r] * rl, 0.f) & 0xffffu); stg[orow * 64 + 32 + r32] = (bf16_t)(cvtpk(o1[r] * rl, 0.f) & 0xffffu); }
        asm volatile("s_waitcnt lgkmcnt(0)" ::: "memory");
#pragma unroll
        for (int i = 0; i < 4; ++i) { const int row = i * 8 + (lane >> 3), ch = lane & 7; const u32x4 v = *(const LAS u32x4*)(stg + row * 64 + ch * 8);
            *(u32x4*)(P + (rowbase + T0 + 32 * j + row) * NP + PC_Q + h * 64 + ch * 8) = v; }
        asm volatile("s_waitcnt lgkmcnt(0)" ::: "memory");
    }
}
}

__device__ __forceinline__ void conv_pass(bf16_t* P, const float* cw, int gtid, int nthreads) {
    for (int it = gtid; it < (M / 16) * 128; it += nthreads) {
        const int c8 = (it & 127) * 8; const size_t r0 = (size_t)(it >> 7) * 16; const int t0 = (int)(r0 & (SEQ - 1));
        float w0[8], w1[8], w2[8], z1[8], z2[8];
        { const f32x4 a = *(const f32x4*)(cw + c8), b = *(const f32x4*)(cw + c8 + 4); w0[0] = a.x; w0[1] = a.y; w0[2] = a.z; w0[3] = a.w; w0[4] = b.x; w0[5] = b.y; w0[6] = b.z; w0[7] = b.w; }
        { const f32x4 a = *(const f32x4*)(cw + D + c8), b = *(const f32x4*)(cw + D + c8 + 4); w1[0] = a.x; w1[1] = a.y; w1[2] = a.z; w1[3] = a.w; w1[4] = b.x; w1[5] = b.y; w1[6] = b.z; w1[7] = b.w; }
        { const f32x4 a = *(const f32x4*)(cw + 2 * D + c8), b = *(const f32x4*)(cw + 2 * D + c8 + 4); w2[0] = a.x; w2[1] = a.y; w2[2] = a.z; w2[3] = a.w; w2[4] = b.x; w2[5] = b.y; w2[6] = b.z; w2[7] = b.w; }
        if (t0 == 0) {
#pragma unroll
            for (int e = 0; e < 8; ++e) { z1[e] = 0.f; z2[e] = 0.f; }
        } else {
            const bf16_t* pa = P + (r0 - 2) * NP + c8; const bf16_t* pb = P + (r0 - 1) * NP + c8;
            const u32x4 ca = *(const u32x4*)(pa + PC_C), va = *(const u32x4*)(pa + PC_VC), cb = *(const u32x4*)(pb + PC_C), vb = *(const u32x4*)(pb + PC_VC);
#pragma unroll
            for (int e = 0; e < 4; ++e) { z2[2 * e] = bflo(ca[e]) * bflo(va[e]); z2[2 * e + 1] = bfhi(ca[e]) * bfhi(va[e]); z1[2 * e] = bflo(cb[e]) * bflo(vb[e]); z1[2 * e + 1] = bfhi(cb[e]) * bfhi(vb[e]); }
        }
#pragma unroll 4
        for (int rr = 0; rr < 16; ++rr) {
            bf16_t* pr = P + (r0 + rr) * NP + c8;
            const u32x4 cc = *(const u32x4*)(pr + PC_C), vv = *(const u32x4*)(pr + PC_VC), bb = *(const u32x4*)(pr + PC_B);
            float z0[8], y[8];
#pragma unroll
            for (int e = 0; e < 4; ++e) { z0[2 * e] = bflo(cc[e]) * bflo(vv[e]); z0[2 * e + 1] = bfhi(cc[e]) * bfhi(vv[e]); }
#pragma unroll
            for (int e = 0; e < 8; ++e) y[e] = w0[e] * z2[e] + w1[e] * z1[e] + w2[e] * z0[e];
            u32x4 o;
#pragma unroll
            for (int e = 0; e < 4; ++e) o[e] = cvtpk(bflo(bb[e]) * y[2 * e], bfhi(bb[e]) * y[2 * e + 1]);
            *(u32x4*)(pr + PC_B) = o;
#pragma unroll
            for (int e = 0; e < 8; ++e) { z2[e] = z1[e]; z1[e] = z0[e]; }
        }
    }
}

struct Args { const float* in[20]; float* out; unsigned char* ws; int ph_lo, ph_hi; };
enum { I_X = 0, I_N1, I_WG1, I_WU1, I_WD1, I_NM, I_WIN, I_CONVW, I_QN, I_KN, I_SINK, I_WCO, I_WAO, I_WBG, I_BBG, I_WOUT, I_N2, I_WG2, I_WU2, I_WD2 };

__global__ void __launch_bounds__(512, 2) fwd(Args a) {
    extern __shared__ __attribute__((aligned(16))) unsigned char lds_raw[];
    LAS unsigned char* lds = (LAS unsigned char*)lds_raw;
    const int tid = threadIdx.x, lane = tid & 63, wave = __builtin_amdgcn_readfirstlane(tid >> 6);
    const int G = gridDim.x, bx = blockIdx.x;
    const int vcu = (G % 8 == 0) ? (bx % 8) * (G / 8) + bx / 8 : bx;
    unsigned char* ws = a.ws;
    bf16_t* W1 = (bf16_t*)(ws + WS_W1); bf16_t* W2 = (bf16_t*)(ws + WS_W2); bf16_t* W3 = (bf16_t*)(ws + WS_W3); bf16_t* W4 = (bf16_t*)(ws + WS_W4);
    bf16_t* W5 = (bf16_t*)(ws + WS_W5); bf16_t* W6 = (bf16_t*)(ws + WS_W6); bf16_t* W7 = (bf16_t*)(ws + WS_W7);
    float* PART1 = (float*)(ws + WS_PART1); float* PART2 = (float*)(ws + WS_PART2);
    bf16_t* XN = (bf16_t*)(ws + WS_XN); bf16_t* P = (bf16_t*)(ws + WS_P); bf16_t* X2G = (bf16_t*)(ws + WS_X2G); bf16_t* HB = (bf16_t*)(ws + WS_H);
    const int lo = a.ph_lo, hi = a.ph_hi;
#ifndef PH_MASK
#define PH_MASK 0x1ff
#endif
#define IN(k) (((PH_MASK >> (k)) & 1) && lo <= (k) && (k) < hi)
#if MK_N_LAUNCHES == 1
#define SEAM(k) do { if (IN(k) && IN((k) + 1)) cg::this_grid().sync(); } while (0)
#else
#define SEAM(k) do { } while (0)
#endif

    if (IN(0)) {
        LAS float* scr = (LAS float*)(lds + wave * 16384);
        const int gw = vcu * 8 + wave, NGW = G * 8;
        constexpr int NB_FF = FF / 32, IT_GU = 16 * NB_FF, IT_DN = (FF / 64) * 32, IT_IN = 16 * 136, IT_BG = 16 * 64, IT_SQ = 16 * 32;
        constexpr int NITEMS = 4 * IT_GU + 2 * IT_DN + IT_IN + IT_BG + 3 * IT_SQ;
        for (int it = gw; it < NITEMS; it += NGW) {
            int r = it;
            if (r < 4 * IT_GU) {
                const int which = r / IT_GU; r -= which * IT_GU; const int kb = r / NB_FF, nb = r % NB_FF, n0 = nb * 32;
                const float* W = a.in[which == 0 ? I_WG1 : which == 1 ? I_WU1 : which == 2 ? I_WG2 : I_WU2];
                p0_transpose_item(W, FF, (which < 2) ? W1 : W6, D, 0, 256 * (n0 >> 7) + 128 * (which & 1) + (n0 & 127), kb * 64, n0, scr, lane, (which < 2) ? nullptr : a.in[I_N2]); continue; }
            r -= 4 * IT_GU;
            if (r < 2 * IT_DN) { const int which = r / IT_DN; r -= which * IT_DN; const int kb = r / 32, nb = r % 32;
                p0_transpose_item(a.in[which ? I_WD2 : I_WD1], D, which ? W7 : W2, FF, 0, nb * 32, kb * 64, nb * 32, scr, lane); continue; }
            r -= 2 * IT_DN;
            if (r < IT_IN) { const int kb = r / 136, nb = r % 136, n0 = nb * 32;
                const int dr = n0 < 1024 ? n0 + 2048 : (n0 < 3072 ? n0 - 1024 : n0);
                p0_transpose_item(a.in[I_WIN], 4352, W3, D, 0, dr, kb * 64, n0, scr, lane, a.in[I_NM]); continue; }
            r -= IT_IN;
            if (r < IT_BG) { const int kb = r / 64, nb = r % 64; p0_transpose_item(a.in[I_WBG], 2048, W3, D, 0, PC_GC + nb * 32, kb * 64, nb * 32, scr, lane, a.in[I_NM]); continue; }
            r -= IT_BG;
            { const int which = r / IT_SQ; r -= which * IT_SQ; const int kb = r / 32, nb = r % 32;
              if (which == 0) p0_transpose_item(a.in[I_WCO], D, W4, 2048, 0, nb * 32, kb * 64, nb * 32, scr, lane);
              else if (which == 1) p0_transpose_item(a.in[I_WAO], D, W4, 2048, 1024, nb * 32, kb * 64, nb * 32, scr, lane);
              else p0_transpose_item(a.in[I_WOUT], D, W5, D, 0, nb * 32, kb * 64, nb * 32, scr, lane); }
        }
        const float* x = a.in[I_X]; const float* g1 = a.in[I_N1];
        f32x4 gv[4];
#pragma unroll
        for (int j = 0; j < 4; ++j) gv[j] = ((const f32x4*)g1)[64 * j + lane];
        for (int m0 = gw * 4; m0 < M; m0 += NGW * 4) {
            f32x4 v[4][4]; float sq[4];
#pragma unroll
            for (int r = 0; r < 4; ++r) { const f32x4* xr = (const f32x4*)(x + (size_t)(m0 + r) * D) + lane;
#pragma unroll
                for (int j = 0; j < 4; ++j) v[r][j] = xr[64 * j]; }
#pragma unroll
            for (int r = 0; r < 4; ++r) { float s = 0.f;
#pragma unroll
                for (int j = 0; j < 4; ++j) s += (v[r][j].x * v[r][j].x + v[r][j].y * v[r][j].y) + (v[r][j].z * v[r][j].z + v[r][j].w * v[r][j].w);
                sq[r] = s; }
#pragma unroll
            for (int o = 1; o < 64; o <<= 1) {
#pragma unroll
                for (int r = 0; r < 4; ++r) sq[r] += __shfl_xor(sq[r], o); }
#pragma unroll
            for (int r = 0; r < 4; ++r) { const float rstd = rsqrtf(sq[r] * (1.f / D) + EPS);
                u32x2* o8 = (u32x2*)(XN + (size_t)(m0 + r) * D) + lane;
#pragma unroll
                for (int j = 0; j < 4; ++j) { u32x2 o; o.x = cvtpk(v[r][j].x * rstd * gv[j].x, v[r][j].y * rstd * gv[j].y); o.y = cvtpk(v[r][j].z * rstd * gv[j].z, v[r][j].w * rstd * gv[j].w); o8[64 * j] = o; } }
        }
        asm volatile("s_waitcnt vmcnt(0) lgkmcnt(0)" ::: "memory"); __syncthreads();
    }
    SEAM(0);
    if (IN(1)) { pg8::Gemm g{XN, W1, D, 2 * FF, D}; pg8::StaticOrder S; S.init(M, 2 * FF, G, bx); pg8::EpiSwiglu E{HB, nullptr}; pg8::gemm_phase(lds, g, S, E); }
    SEAM(1);
    LAS float* red = (LAS float*)(lds + RING_BYTES);
    if (IN(2)) { pg8::Gemm g{HB, W2, FF, D, FF}; pg8::StaticOrder S; S.init(M, D, G, bx); pg8::EpiResid<0> E{a.in[I_X], nullptr, nullptr, XN, 0.5f, PART1, red}; pg8::gemm_phase(lds, g, S, E); }
    SEAM(2);
    if (IN(3)) { pg8::Gemm g{XN, W3, D, NP, D}; pg8::StaticOrder S; S.init(M, NP, G, bx); pg8::EpiProj E{P, PART1, a.in[I_BBG]}; pg8::gemm_phase(lds, g, S, E); }
    SEAM(3);
    if (IN(4)) {
        conv_pass(P, a.in[I_CONVW], vcu * 512 + tid, G * 512);
        {
            att::KVRegs R; int unit = vcu;
            if (unit < 1024) att::kv_load(R, P, unit, tid);
            for (; unit < 1024; unit += G) {
                att::kv_write(R, lds, a.in[I_KN], tid);
                __syncthreads();
                if (unit + G < 1024) att::kv_load(R, P, unit + G, tid);
                att::attn_compute(lds, P, a.in[I_QN], a.in[I_SINK], unit, wave, lane);
                __syncthreads();
            }
        }
        asm volatile("s_waitcnt vmcnt(0) lgkmcnt(0)" ::: "memory"); __syncthreads();
    }
    SEAM(4);
    bf16_t* MG = (bf16_t*)a.out;
    if (IN(5)) { pg8::Gemm g{P + PC_B, W4, NP, D, 2048}; pg8::StaticOrder S; S.init(M, D, G, bx); pg8::EpiMix E{P, MG}; pg8::gemm_phase(lds, g, S, E); }
    SEAM(5);
    if (IN(6)) { pg8::Gemm g{MG, W5, D, D, D}; pg8::StaticOrder S; S.init(M, D, G, bx); pg8::EpiResid<1> E{nullptr, XN, nullptr, X2G, 1.0f, PART2, red}; pg8::gemm_phase(lds, g, S, E); }
    SEAM(6);
    if (IN(7)) { pg8::Gemm g{X2G, W6, D, 2 * FF, D}; pg8::StaticOrder S; S.init(M, 2 * FF, G, bx); pg8::EpiSwiglu E{HB, PART2}; pg8::gemm_phase(lds, g, S, E); }
    SEAM(7);
    if (IN(8)) { pg8::Gemm g{HB, W7, FF, D, FF}; pg8::StaticOrder S; S.init(M, D, G, bx); pg8::EpiResid<2> E{nullptr, X2G, a.out, nullptr, 0.5f, nullptr, red}; pg8::gemm_phase(lds, g, S, E); }
#undef IN
#undef SEAM
}

extern "C" void kernel_launch(void* const* d_in, const int* in_sizes, int n_in, void* d_out, int out_size, void* d_ws, size_t ws_size, hipStream_t stream) {
    static int grid = 0;
    if (grid == 0) {
        if (n_in != 20 || in_sizes[0] != M * D || out_size != M * D || ws_size < WS_END) { fprintf(stderr, "kernel_launch: unexpected shapes (n_in %d, in0 %d, out %d, ws %zu < %zu)\n", n_in, n_in > 0 ? in_sizes[0] : -1, out_size, ws_size, (size_t)WS_END); grid = -1; return; }
        int dev = 0, cus = 0, per_cu = 0;
        hipGetDevice(&dev); hipDeviceGetAttribute(&cus, hipDeviceAttributeMultiprocessorCount, dev);
        if (hipFuncSetAttribute((const void*)fwd, hipFuncAttributeMaxDynamicSharedMemorySize, LDS_BYTES) != hipSuccess) { fprintf(stderr, "kernel_launch: hipFuncSetAttribute failed\n"); grid = -1; return; }
        hipOccupancyMaxActiveBlocksPerMultiprocessor(&per_cu, (const void*)fwd, 512, LDS_BYTES);
        (void)hipGetLastError();
        if (per_cu < 1) per_cu = 1;
        grid = cus * 1;
        fprintf(stderr, "kernel_launch: cus %d per_cu %d grid %d\n", cus, per_cu, grid);
    }
    if (grid < 0) return;
    Args a{};
    for (int i = 0; i < 20; ++i) a.in[i] = (const float*)d_in[i];
    a.out = (float*)d_out; a.ws = (unsigned char*)d_ws;
#if MK_N_LAUNCHES == 1
    a.ph_lo = 0; a.ph_hi = 9;
    void* args[] = {&a};
    hipError_t e = hipLaunchCooperativeKernel((const void*)fwd, dim3(grid), dim3(512), args, LDS_BYTES, stream);
    if (e != hipSuccess) fprintf(stderr, "cooperative launch failed: %s (grid %d)\n", hipGetErrorString(e), grid);
#else
    for (int p = 0; p < 9; ++p) { a.ph_lo = p; a.ph_hi = p + 1; hipLaunchKernelGGL(fwd, dim3(grid), dim3(512), LDS_BYTES, stream, a); }
#endif
}
```

```cpp
#include <hip/hip_runtime.h>
#include <hip/hip_cooperative_groups.h>
#include <cstdio>
#include <cstdint>
namespace cg = cooperative_groups;

#ifndef MK_N_LAUNCHES
#define MK_N_LAUNCHES 1
#endif

#define LAS __attribute__((address_space(3)))
typedef unsigned short bf16_t;
typedef short bf16x8 __attribute__((ext_vector_type(8)));
typedef float f32x4 __attribute__((ext_vector_type(4)));
typedef float f32x16 __attribute__((ext_vector_type(16)));
typedef unsigned u32x4 __attribute__((ext_vector_type(4)));
typedef unsigned u32x2 __attribute__((ext_vector_type(2)));
typedef float f32x2_t __attribute__((ext_vector_type(2)));
typedef __bf16 bf16x2_t __attribute__((ext_vector_type(2)));

constexpr int M = 65536, D = 1024, FF = 2816, SEQ = 2048;
constexpr int NP = 6400;
constexpr int PC_C = 0, PC_VC = 1024, PC_B = 2048, PC_Q = 3072, PC_K = 4096, PC_V = 4224, PC_GC = 4352, PC_GA = 5376;
constexpr float EPS = 1e-6f;
constexpr float LOG2E = 1.4426950408889634f;

constexpr size_t MiB = 1u << 20;
constexpr size_t WS_W1 = 0;
constexpr size_t WS_W2 = 11 * MiB;
constexpr size_t WS_W3 = 17 * MiB;
constexpr size_t WS_W4 = 30 * MiB;
constexpr size_t WS_W5 = 34 * MiB;
constexpr size_t WS_W6 = 36 * MiB;
constexpr size_t WS_W7 = 47 * MiB;
constexpr size_t WS_PART1 = 53 * MiB;
constexpr size_t WS_PART2 = 57 * MiB;
constexpr size_t WS_BAR = 61 * MiB;
constexpr size_t WS_XN = 64 * MiB;
constexpr size_t WS_P = 192 * MiB;
constexpr size_t WS_X2G = WS_P;
constexpr size_t WS_H = WS_P + 128 * MiB;
constexpr size_t WS_END = WS_P + 800 * MiB;

constexpr int RING_BYTES = 131072;
constexpr int LDS_BYTES = 147456;

__device__ __forceinline__ unsigned cvtpk(float lo, float hi) { f32x2_t v = {lo, hi}; bf16x2_t b = __builtin_convertvector(v, bf16x2_t); return __builtin_bit_cast(unsigned, b); }
__device__ __forceinline__ float bflo(unsigned w) { return __uint_as_float(w << 16); }
__device__ __forceinline__ float bfhi(unsigned w) { return __uint_as_float(w & 0xffff0000u); }
__device__ __forceinline__ float sigmoidf_(float z) { return __builtin_amdgcn_rcpf(1.f + __expf(-z)); }
__device__ __forceinline__ float rstd_from_parts(const float* p) {
    const f32x4 a = *(const f32x4*)p;
    return rsqrtf(((a.x + a.y) + (a.z + a.w)) * (1.0f / 1024.0f) + EPS);
}

namespace pg8 {
constexpr int BM = 256, BK = 64, HALF = 128, HTB = HALF * BK * 2, STAGE_BYTES = 8 * HTB, NXCD = 8, WGM = 8;
__host__ __device__ __forceinline__ int lds_byte(int r, int c) { const int st = (r >> 4) * 2 + (c >> 5), rr = r & 15, cc = c & 31, ob = rr * 64 + cc * 2; return st * 1024 + (ob ^ (((ob >> 9) & 1) << 5)); }
__host__ __device__ __forceinline__ void stage_rc(int b, int& R, int& C) { const int st = b / 1024, sb = b % 1024, swz = sb ^ (((sb >> 9) & 1) << 5); R = (st >> 1) * 16 + swz / 64; C = (st & 1) * 32 + (swz % 64) / 2; }
__host__ __device__ __forceinline__ int perm32(int rho) { const int n = rho >> 4, i = rho & 15; return 8 * (i >> 2) + 4 * n + (i & 3); }

struct Unit { int pm, pn; };
struct Gemm { const bf16_t* A; const bf16_t* Bt; int lda, N, K; };

struct StaticOrder {
    int nM, nN, nwg, G, c;
    __device__ void init(int Mr, int N, int G_, int c_) { nM = Mr / BM; nN = N / BM; nwg = nM * nN; G = G_; c = c_; }
    __device__ bool next(int i, Unit& u) const {
        const long L = (long)i * G + c; if (L >= nwg) return false;
        int wgid = (int)L; { const int q = nwg / NXCD, r = nwg % NXCD, xcd = wgid % NXCD, off = wgid / NXCD; wgid = (xcd < r ? xcd * (q + 1) : r * (q + 1) + (xcd - r) * q) + off; }
        const int nig = WGM * nN, gid = wgid / nig, fm = gid * WGM, gsz = (nM - fm) < WGM ? (nM - fm) : WGM;
        u.pm = fm + ((wgid % nig) % gsz); u.pn = (wgid % nig) / gsz; return true;
    }
};

typedef f32x4 Acc[2][2][4][2];

struct EpiSwiglu {
    static constexpr bool HAS_MID = false; static constexpr int MID_T = -1;
    bf16_t* H; const float* part;
    __device__ __forceinline__ void mid(Acc&, const Unit&, int, int, int, int) const {}
    __device__ __forceinline__ void operator()(const Acc& acc, const Unit& u, int wr, int wc, int fr, int fq) const {
        const int row0 = u.pm * BM + wr * 64 + fr, col0 = u.pn * HALF + wc * 32 + 8 * fq;
#pragma unroll
        for (int ai = 0; ai < 2; ++ai)
#pragma unroll
            for (int m = 0; m < 4; ++m) {
                const int row = row0 + ai * HALF + m * 16;
                const float rs = part ? rstd_from_parts(part + (size_t)row * 4) : 1.0f;
                float h[8];
#pragma unroll
                for (int n = 0; n < 2; ++n)
#pragma unroll
                    for (int i = 0; i < 4; ++i) { const float g = acc[ai][0][m][n][i] * rs, up = acc[ai][1][m][n][i] * rs; h[4 * n + i] = g * sigmoidf_(g) * up; }
                u32x4 w; w.x = cvtpk(h[0], h[1]); w.y = cvtpk(h[2], h[3]); w.z = cvtpk(h[4], h[5]); w.w = cvtpk(h[6], h[7]);
                *(u32x4*)(H + (size_t)row * FF + col0) = w;
            }
    }
};

template <int MODE> struct EpiResid {
    static constexpr bool HAS_MID = false; static constexpr int MID_T = -1;
    const float* basef; const bf16_t* baseb; float* outf; bf16_t* outb; float alpha; float* part; LAS float* red;
    __device__ __forceinline__ void mid(Acc&, const Unit&, int, int, int, int) const {}
    __device__ __forceinline__ void operator()(const Acc& acc, const Unit& u, int wr, int wc, int fr, int fq) const {
        const int row0 = u.pm * BM + wr * 64 + fr, col0 = u.pn * BM + wc * 32 + 8 * fq;
#pragma unroll
        for (int ai = 0; ai < 2; ++ai)
#pragma unroll
            for (int m = 0; m < 4; ++m) {
                const int row = row0 + ai * HALF + m * 16; float ss = 0.f;
#pragma unroll
                for (int bj = 0; bj < 2; ++bj) {
                    const size_t off = (size_t)row * D + col0 + bj * HALF;
                    f32x4 b0, b1;
                    if (MODE == 0) { b0 = *(const f32x4*)(basef + off); b1 = *(const f32x4*)(basef + off + 4); }
                    else { const u32x4 w = *(const u32x4*)(baseb + off); b0 = (f32x4){bflo(w.x), bfhi(w.x), bflo(w.y), bfhi(w.y)}; b1 = (f32x4){bflo(w.z), bfhi(w.z), bflo(w.w), bfhi(w.w)}; }
                    const f32x4 v0 = b0 + acc[ai][bj][m][0] * alpha, v1 = b1 + acc[ai][bj][m][1] * alpha;
                    if (MODE == 2) { *(f32x4*)(outf + off) = v0; *(f32x4*)(outf + off + 4) = v1; }
                    else {
                        ss += (v0.x * v0.x + v0.y * v0.y) + (v0.z * v0.z + v0.w * v0.w) + (v1.x * v1.x + v1.y * v1.y) + (v1.z * v1.z + v1.w * v1.w);
                        u32x4 w; w.x = cvtpk(v0.x, v0.y); w.y = cvtpk(v0.z, v0.w); w.z = cvtpk(v1.x, v1.y); w.w = cvtpk(v1.z, v1.w); *(u32x4*)(outb + off) = w;
                    }
                }
                if (MODE != 2) { ss += __shfl_xor(ss, 16); ss += __shfl_xor(ss, 32); if (fq == 0) red[(ai * HALF + wr * 64 + m * 16 + fr) * 4 + wc] = ss; }
            }
        if (MODE != 2) {
            asm volatile("s_waitcnt lgkmcnt(0)" ::: "memory"); __builtin_amdgcn_s_barrier(); asm volatile("" ::: "memory");
            const int t = threadIdx.x;
            if (t < 256) { const f32x4 r = *(const LAS f32x4*)(red + t * 4); part[(size_t)(u.pm * BM + t) * 4 + u.pn] = (r.x + r.y) + (r.z + r.w); }
            asm volatile("s_waitcnt lgkmcnt(0)" ::: "memory"); __builtin_amdgcn_s_barrier(); asm volatile("" ::: "memory");
        }
    }
};

struct EpiProj {
    static constexpr bool HAS_MID = false; static constexpr int MID_T = -1;
    bf16_t* P; const float* part; const float* bias;
    __device__ __forceinline__ void mid(Acc&, const Unit&, int, int, int, int) const {}
    __device__ __forceinline__ void operator()(const Acc& acc, const Unit& u, int wr, int wc, int fr, int fq) const {
        const int row0 = u.pm * BM + wr * 64 + fr, col0 = u.pn * BM + wc * 32 + 8 * fq; const bool gate = u.pn >= 17;
        f32x4 bv[2][2];
#pragma unroll
        for (int bj = 0; bj < 2; ++bj)
#pragma unroll
            for (int n = 0; n < 2; ++n) bv[bj][n] = gate ? *(const f32x4*)(bias + (col0 - PC_GC) + bj * HALF + 4 * n) : (f32x4){0.f, 0.f, 0.f, 0.f};
#pragma unroll
        for (int ai = 0; ai < 2; ++ai)
#pragma unroll
            for (int m = 0; m < 4; ++m) {
                const int row = row0 + ai * HALF + m * 16; const float rs = rstd_from_parts(part + (size_t)row * 4);
#pragma unroll
                for (int bj = 0; bj < 2; ++bj) {
                    f32x4 v0 = acc[ai][bj][m][0] * rs + bv[bj][0], v1 = acc[ai][bj][m][1] * rs + bv[bj][1];
                    if (gate) { v0.x = sigmoidf_(v0.x); v0.y = sigmoidf_(v0.y); v0.z = sigmoidf_(v0.z); v0.w = sigmoidf_(v0.w); v1.x = sigmoidf_(v1.x); v1.y = sigmoidf_(v1.y); v1.z = sigmoidf_(v1.z); v1.w = sigmoidf_(v1.w); }
                    u32x4 w; w.x = cvtpk(v0.x, v0.y); w.y = cvtpk(v0.z, v0.w); w.z = cvtpk(v1.x, v1.y); w.w = cvtpk(v1.z, v1.w);
                    *(u32x4*)(P + (size_t)row * NP + col0 + bj * HALF) = w;
                }
            }
    }
};

struct EpiMix {
    static constexpr bool HAS_MID = true; static constexpr int MID_T = 16;
    const bf16_t* P; bf16_t* out;
    __device__ __forceinline__ void mid(Acc& acc, const Unit& u, int wr, int wc, int fr, int fq) const {
        int row0 = u.pm * BM + wr * 64 + fr; const int col0 = u.pn * BM + wc * 32 + 8 * fq;
        asm volatile("" : "+v"(row0));
#pragma unroll
        for (int ai = 0; ai < 2; ++ai)
#pragma unroll
            for (int m = 0; m < 4; ++m) {
                const int row = row0 + ai * HALF + m * 16;
#pragma unroll
                for (int bj = 0; bj < 2; ++bj) {
                    const bf16_t* pr = P + (size_t)row * NP + col0 + bj * HALF;
                    const u32x4 gc = *(const u32x4*)(pr + PC_GC), ga = *(const u32x4*)(pr + PC_GA);
                    f32x4 r0, r1;
                    r0.x = bflo(gc.x) * __builtin_amdgcn_rcpf(fmaxf(bflo(ga.x), 1e-30f)); r0.y = bfhi(gc.x) * __builtin_amdgcn_rcpf(fmaxf(bfhi(ga.x), 1e-30f));
                    r0.z = bflo(gc.y) * __builtin_amdgcn_rcpf(fmaxf(bflo(ga.y), 1e-30f)); r0.w = bfhi(gc.y) * __builtin_amdgcn_rcpf(fmaxf(bfhi(ga.y), 1e-30f));
                    r1.x = bflo(gc.z) * __builtin_amdgcn_rcpf(fmaxf(bflo(ga.z), 1e-30f)); r1.y = bfhi(gc.z) * __builtin_amdgcn_rcpf(fmaxf(bfhi(ga.z), 1e-30f));
                    r1.z = bflo(gc.w) * __builtin_amdgcn_rcpf(fmaxf(bflo(ga.w), 1e-30f)); r1.w = bfhi(gc.w) * __builtin_amdgcn_rcpf(fmaxf(bfhi(ga.w), 1e-30f));
                    acc[ai][bj][m][0] *= r0; acc[ai][bj][m][1] *= r1;
                }
                if (m & 1) asm volatile("" ::: "memory");
            }
    }
    __device__ __forceinline__ void operator()(const Acc& acc, const Unit& u, int wr, int wc, int fr, int fq) const {
        const int row0 = u.pm * BM + wr * 64 + fr, col0 = u.pn * BM + wc * 32 + 8 * fq;
#pragma unroll
        for (int ai = 0; ai < 2; ++ai)
#pragma unroll
            for (int m = 0; m < 4; ++m) {
                const int row = row0 + ai * HALF + m * 16;
#pragma unroll
                for (int bj = 0; bj < 2; ++bj) {
                    const u32x4 ga = *(const u32x4*)(P + (size_t)row * NP + col0 + bj * HALF + PC_GA);
                    f32x4 g0, g1;
                    g0.x = fmaxf(bflo(ga.x), 1e-30f); g0.y = fmaxf(bfhi(ga.x), 1e-30f); g0.z = fmaxf(bflo(ga.y), 1e-30f); g0.w = fmaxf(bfhi(ga.y), 1e-30f);
                    g1.x = fmaxf(bflo(ga.z), 1e-30f); g1.y = fmaxf(bfhi(ga.z), 1e-30f); g1.z = fmaxf(bflo(ga.w), 1e-30f); g1.w = fmaxf(bfhi(ga.w), 1e-30f);
                    const f32x4 v0 = acc[ai][bj][m][0] * g0, v1 = acc[ai][bj][m][1] * g1;
                    u32x4 w; w.x = cvtpk(v0.x, v0.y); w.y = cvtpk(v0.z, v0.w); w.z = cvtpk(v1.x, v1.y); w.w = cvtpk(v1.z, v1.w);
                    *(u32x4*)(out + (size_t)row * D + col0 + bj * HALF) = w;
                }
            }
    }
};

template <class Epi>
__device__ __forceinline__ void gemm_phase(LAS unsigned char* lds, const Gemm g, const StaticOrder& S, const Epi& E) {
    const int tid = threadIdx.x, wid = __builtin_amdgcn_readfirstlane(tid >> 6), lane = tid & 63, wr = wid >> 2, wc = wid & 3, fr = lane & 15, fq = lane >> 4;
    const int K = g.K, nt = K / BK, lda = g.lda;
    unsigned voffA[2], voffB[2];
#pragma unroll
    for (int i = 0; i < 2; ++i) { int R, C; stage_rc(tid * 16 + i * 8192, R, C); const int Rb = (R & ~31) + perm32(R & 31);
        voffA[i] = (unsigned)(R * lda + C) * 2u; voffB[i] = (unsigned)(Rb * K + C) * 2u; }
    const size_t kstep = (size_t)(BK * 2);
    const size_t hstepA = (size_t)HALF * lda * 2, hstepB = (size_t)HALF * K * 2;
    const size_t tstepA = 2 * hstepA, tstepB = 2 * hstepB;
    const unsigned ldsw = (unsigned)wid * 1024u;
    const int aoff = lds_byte(wr * 64 + fr, fq * 8), boff = lds_byte(wc * 32 + fr, fq * 8);
#define PG8_SA(b, h) (((b) * 2 + (h)) * HTB)
#define PG8_SB(b, h) ((4 + (b) * 2 + (h)) * HTB)
#define PG8_STAGE(bufoff, gbase, voff) do { _Pragma("unroll") for (int _i = 0; _i < 2; ++_i) \
        __builtin_amdgcn_global_load_lds((const unsigned*)((const char*)(gbase) + (voff)[_i]), (LAS unsigned*)(lds + (bufoff) + ldsw + _i * 8192), 16, 0, 0); } while (0)
#define PG8_LDA(dst, b, h) do { _Pragma("unroll") for (int m = 0; m < 4; ++m) _Pragma("unroll") for (int k = 0; k < 2; ++k) dst[m][k] = *(const LAS bf16x8*)(lds + PG8_SA(b, h) + aoff + m * 2048 + k * 1024); } while (0)
#define PG8_LDB(dst, b, h) do { _Pragma("unroll") for (int n = 0; n < 2; ++n) _Pragma("unroll") for (int k = 0; k < 2; ++k) dst[n][k] = *(const LAS bf16x8*)(lds + PG8_SB(b, h) + boff + n * 2048 + k * 1024); } while (0)
#define PG8_MMA(ai, bj, At, Bt) do { __builtin_amdgcn_s_setprio(1); _Pragma("unroll") for (int m = 0; m < 4; ++m) _Pragma("unroll") for (int n = 0; n < 2; ++n) _Pragma("unroll") for (int k = 0; k < 2; ++k) \
        acc[ai][bj][m][n] = __builtin_amdgcn_mfma_f32_16x16x32_bf16(Bt[n][k], At[m][k], acc[ai][bj][m][n], 0, 0, 0); __builtin_amdgcn_s_setprio(0); } while (0)
#define PG8_WAIT_V(n) asm volatile("s_waitcnt vmcnt(" #n ")" ::: "memory")
#define PG8_WAIT_L(n) asm volatile("s_waitcnt lgkmcnt(" #n ")" ::: "memory")
#define PG8_BAR __builtin_amdgcn_s_barrier()
#define PG8_SCHED __builtin_amdgcn_sched_barrier(0)
    Unit cur, nxt; int ui = 0;
    if (!S.next(0, cur)) return;
    Acc acc;
#pragma unroll
    for (int a = 0; a < 2; ++a)
#pragma unroll
        for (int b = 0; b < 2; ++b)
#pragma unroll
            for (int m = 0; m < 4; ++m)
#pragma unroll
                for (int n = 0; n < 2; ++n) acc[a][b][m][n] = (f32x4){0.f, 0.f, 0.f, 0.f};
    bf16x8 At[4][2], B0[2][2], B1[2][2];
    const char* cA = (const char*)g.A + (size_t)cur.pm * tstepA; const char* cB = (const char*)g.Bt + (size_t)cur.pn * tstepB;
    PG8_STAGE(PG8_SB(0, 0), cB, voffB); PG8_STAGE(PG8_SB(0, 1), cB + hstepB, voffB); PG8_STAGE(PG8_SA(0, 0), cA, voffA); PG8_STAGE(PG8_SA(0, 1), cA + hstepA, voffA);
    if (wr == 1) PG8_BAR;
    PG8_WAIT_V(2); PG8_BAR;
    PG8_STAGE(PG8_SB(1, 0), cB + kstep, voffB); PG8_STAGE(PG8_SA(1, 0), cA + kstep, voffA); PG8_STAGE(PG8_SB(1, 1), cB + hstepB + kstep, voffB);
    PG8_WAIT_V(6); PG8_BAR;
    for (;;) {
        const bool has_next = S.next(ui + 1, nxt);
        const char* nA = has_next ? (const char*)g.A + (size_t)nxt.pm * tstepA : cA; const char* nB = has_next ? (const char*)g.Bt + (size_t)nxt.pn * tstepB : cB;
        for (int t = 0; t < nt; t += 2) {
            if constexpr (Epi::HAS_MID) { if (t == Epi::MID_T) { E.mid(acc, cur, wr, wc, fr, fq); PG8_SCHED; } }
            const bool last = (t == nt - 2);
            const char* a1 = cA + (size_t)(t + 1) * kstep;
            const char* a2 = last ? nA : cA + (size_t)(t + 2) * kstep; const char* b2 = last ? nB : cB + (size_t)(t + 2) * kstep;
            const char* a3 = a2 + kstep; const char* b3 = b2 + kstep;
            PG8_LDB(B0, 0, 0); PG8_LDB(B1, 0, 1); PG8_SCHED; PG8_LDA(At, 0, 0); PG8_STAGE(PG8_SA(1, 1), a1 + hstepA, voffA);
            PG8_WAIT_V(8); PG8_WAIT_L(0); PG8_BAR; PG8_MMA(0, 0, At, B0); PG8_MMA(0, 1, At, B1); PG8_BAR; PG8_SCHED;
            PG8_LDA(At, 0, 1); PG8_STAGE(PG8_SB(0, 0), b2, voffB); PG8_STAGE(PG8_SB(0, 1), b2 + hstepB, voffB); PG8_STAGE(PG8_SA(0, 0), a2, voffA);
            PG8_WAIT_V(8); PG8_WAIT_L(0); PG8_BAR; PG8_MMA(1, 0, At, B0); PG8_MMA(1, 1, At, B1); PG8_BAR; PG8_SCHED;
            PG8_LDB(B0, 1, 0); PG8_LDB(B1, 1, 1); PG8_SCHED; PG8_LDA(At, 1, 0); PG8_STAGE(PG8_SA(0, 1), a2 + hstepA, voffA);
            PG8_WAIT_V(8); PG8_WAIT_L(0); PG8_BAR; PG8_MMA(0, 0, At, B0); PG8_MMA(0, 1, At, B1); PG8_BAR; PG8_SCHED;
            PG8_LDA(At, 1, 1); PG8_STAGE(PG8_SB(1, 0), b3, voffB); PG8_STAGE(PG8_SB(1, 1), b3 + hstepB, voffB); PG8_STAGE(PG8_SA(1, 0), a3, voffA);
            PG8_WAIT_V(8); PG8_WAIT_L(0); PG8_BAR; PG8_MMA(1, 0, At, B0); PG8_MMA(1, 1, At, B1); PG8_BAR; PG8_SCHED;
        }
        if (wr == 0) PG8_BAR;
        E(acc, cur, wr, wc, fr, fq);
        if (!has_next) break;
#pragma unroll
        for (int a = 0; a < 2; ++a)
#pragma unroll
            for (int b = 0; b < 2; ++b)
#pragma unroll
                for (int m = 0; m < 4; ++m)
#pragma unroll
                    for (int n = 0; n < 2; ++n) acc[a][b][m][n] = (f32x4){0.f, 0.f, 0.f, 0.f};
        cur = nxt; cA = nA; cB = nB; ++ui;
        if (wr == 1) PG8_BAR;
    }
    PG8_WAIT_V(0);
    PG8_BAR;
#undef PG8_SA
#undef PG8_SB
#undef PG8_STAGE
#undef PG8_LDA
#undef PG8_LDB
#undef PG8_MMA
#undef PG8_WAIT_V
#undef PG8_WAIT_L
#undef PG8_BAR
#undef PG8_SCHED
}
}

__device__ __forceinline__ float wave_sum(float v) {
#pragma unroll
    for (int o = 1; o < 64; o <<= 1) v += __shfl_xor(v, o);
    return v;
}
__device__ __forceinline__ void p0_transpose_item(const float* W, int N, bf16_t* WT, int ldk, int koff, int drow0, int k0, int n0, LAS float* scr, int lane, const float* ksc = nullptr) {
#pragma unroll 8
    for (int i = 0; i < 32; ++i) { const int kk = 2 * i + (lane >> 5); const float sc = ksc ? ksc[k0 + kk] : 1.0f; scr[kk * 33 + (lane & 31)] = W[(size_t)(k0 + kk) * N + n0 + (lane & 31)] * sc; }
    asm volatile("s_waitcnt lgkmcnt(0)" ::: "memory");
    const int c = lane & 7;
#pragma unroll
    for (int j = 0; j < 4; ++j) { const int n = (lane >> 3) + 8 * j; const LAS float* s = scr + (8 * c) * 33 + n;
        u32x4 o; o.x = cvtpk(s[0 * 33], s[1 * 33]); o.y = cvtpk(s[2 * 33], s[3 * 33]); o.z = cvtpk(s[4 * 33], s[5 * 33]); o.w = cvtpk(s[6 * 33], s[7 * 33]);
        *(u32x4*)(WT + (size_t)(drow0 + n) * ldk + koff + k0 + 8 * c) = o; }
    asm volatile("s_waitcnt lgkmcnt(0)" ::: "memory");
}

namespace att {
constexpr int KPB = 144;
constexpr int VP = 260;
constexpr int LDS_K = 0, LDS_V = 36864, LDS_WS = 70144, LDS_OST = 72192, LDS_END = 104960;
__device__ __forceinline__ int crow(int r, int hi) { return (r & 3) + 8 * (r >> 2) + 4 * hi; }

struct KVRegs { u32x4 kr[4], vr[4]; };
__device__ __forceinline__ void kv_load(KVRegs& R, const bf16_t* P, int unit, int tid) {
    const int hk = unit & 1, n = (unit >> 1) & 15, b = unit >> 5;
    const int kk = tid >> 1, half = tid & 1; const int kp = n * 128 - 128 + kk;
    if (kp >= 0) { const bf16_t* pr = P + ((size_t)b * SEQ + kp) * NP + PC_K + hk * 64 + half * 32;
#pragma unroll
        for (int i = 0; i < 4; ++i) { R.kr[i] = *(const u32x4*)(pr + 8 * i); R.vr[i] = *(const u32x4*)(pr + 128 + 8 * i); } }
    else {
#pragma unroll
        for (int i = 0; i < 4; ++i) { R.kr[i] = (u32x4){0u, 0u, 0u, 0u}; R.vr[i] = (u32x4){0u, 0u, 0u, 0u}; } }
}
__device__ __forceinline__ void kv_write(const KVRegs& R, LAS unsigned char* lds, const float* kn_w, int tid) {
    const int kk = tid >> 1, half = tid & 1;
    float ss = 0.f;
#pragma unroll
    for (int i = 0; i < 4; ++i)
#pragma unroll
        for (int e = 0; e < 4; ++e) { const float a = bflo(R.kr[i][e]), c = bfhi(R.kr[i][e]); ss += a * a + c * c; }
    ss += __shfl_xor(ss, 1);
    const float rs = rsqrtf(ss * (1.0f / 64.0f) + EPS);
#pragma unroll
    for (int i = 0; i < 4; ++i) {
        const f32x4 w0 = *(const f32x4*)(kn_w + half * 32 + 8 * i), w1 = *(const f32x4*)(kn_w + half * 32 + 8 * i + 4);
        u32x4 o;
        o.x = cvtpk(bflo(R.kr[i].x) * rs * w0.x, bfhi(R.kr[i].x) * rs * w0.y); o.y = cvtpk(bflo(R.kr[i].y) * rs * w0.z, bfhi(R.kr[i].y) * rs * w0.w);
        o.z = cvtpk(bflo(R.kr[i].z) * rs * w1.x, bfhi(R.kr[i].z) * rs * w1.y); o.w = cvtpk(bflo(R.kr[i].w) * rs * w1.z, bfhi(R.kr[i].w) * rs * w1.w);
        *(LAS u32x4*)(lds + LDS_K + kk * KPB + half * 64 + 16 * i) = o;
    }
#pragma unroll
    for (int i = 0; i < 4; ++i)
#pragma unroll
        for (int e = 0; e < 8; ++e) {
            const unsigned short val = (unsigned short)((R.vr[i][e >> 1] >> (16 * (e & 1))) & 0xffffu);
            *(LAS unsigned short*)(lds + LDS_V + ((half * 32 + 8 * i + e) * VP + kk) * 2) = val;
        }
}
__device__ __forceinline__ void attn_compute(LAS unsigned char* lds, bf16_t* P, const float* qn_w, const float* sinks, int unit, int wid, int lane) {
    const int hk = unit & 1, n = (unit >> 1) & 15, b = unit >> 5;
    const int T0 = n * 128; const size_t rowbase = (size_t)b * SEQ;
    const int h = hk * 8 + wid, r32 = lane & 31, hi = lane >> 5;
    const float sink2 = sinks[h] * LOG2E;
    LAS float* wsf = (LAS float*)(lds + LDS_WS) + wid * 64;
    LAS bf16_t* stg = (LAS bf16_t*)(lds + LDS_OST) + wid * 2048;
    const float NEG = -1e30f;
    u32x4 qnext[4];
    { const bf16_t* qp = P + (rowbase + T0 + r32) * NP + PC_Q + h * 64;
#pragma unroll
      for (int d0 = 0; d0 < 4; ++d0) qnext[d0] = *(const u32x4*)(qp + 16 * d0 + 8 * hi); }
#pragma unroll 1
    for (int j = 0; j < 4; ++j) {
        u32x4 qraw[4]; float ss = 0.f;
#pragma unroll
        for (int d0 = 0; d0 < 4; ++d0) { qraw[d0] = qnext[d0];
#pragma unroll
            for (int e = 0; e < 4; ++e) { const float a = bflo(qraw[d0][e]), c = bfhi(qraw[d0][e]); ss += a * a + c * c; } }
        if (j < 3) { const bf16_t* qp = P + (rowbase + T0 + 32 * (j + 1) + r32) * NP + PC_Q + h * 64;
#pragma unroll
            for (int d0 = 0; d0 < 4; ++d0) qnext[d0] = *(const u32x4*)(qp + 16 * d0 + 8 * hi); }
        ss += __shfl_xor(ss, 32);
        const float rs = rsqrtf(ss * (1.0f / 64.0f) + EPS) * (0.125f * LOG2E);
        bf16x8 qr[4];
#pragma unroll
        for (int d0 = 0; d0 < 4; ++d0) {
            const f32x4 w0 = *(const f32x4*)(qn_w + 16 * d0 + 8 * hi), w1 = *(const f32x4*)(qn_w + 16 * d0 + 8 * hi + 4);
            u32x4 o;
            o.x = cvtpk(bflo(qraw[d0].x) * rs * w0.x, bfhi(qraw[d0].x) * rs * w0.y); o.y = cvtpk(bflo(qraw[d0].y) * rs * w0.z, bfhi(qraw[d0].y) * rs * w0.w);
            o.z = cvtpk(bflo(qraw[d0].z) * rs * w1.x, bfhi(qraw[d0].z) * rs * w1.y); o.w = cvtpk(bflo(qraw[d0].w) * rs * w1.z, bfhi(qraw[d0].w) * rs * w1.w);
            qr[d0] = __builtin_bit_cast(bf16x8, o);
        }
        f32x16 S[5];
#pragma unroll
        for (int c = 0; c < 5; ++c) {
            f32x16 p;
#pragma unroll
            for (int r = 0; r < 16; ++r) p[r] = 0.f;
#pragma unroll
            for (int d0 = 0; d0 < 4; ++d0) {
                const bf16x8 kf = *(const LAS bf16x8*)(lds + LDS_K + (32 * (j + c) + r32) * KPB + (16 * d0 + 8 * hi) * 2);
                p = __builtin_amdgcn_mfma_f32_32x32x16_bf16(kf, qr[d0], p, 0, 0, 0);
            }
            S[c] = p;
        }
#pragma unroll
        for (int r = 0; r < 16; ++r) { const int kl = crow(r, hi); if (!(kl > r32)) S[0][r] = NEG; if (!(kl <= r32)) S[4][r] = NEG; }
        if (n == 0) {
#pragma unroll
            for (int c = 0; c < 5; ++c) if (j + c < 4) {
#pragma unroll
                for (int r = 0; r < 16; ++r) S[c][r] = NEG; }
        }
        float mx = sink2;
#pragma unroll
        for (int c = 0; c < 5; ++c)
#pragma unroll
            for (int r = 0; r < 16; ++r) mx = fmaxf(mx, S[c][r]);
        mx = fmaxf(mx, __shfl_xor(mx, 32));
        float l = 0.f;
#pragma unroll
        for (int c = 0; c < 5; ++c)
#pragma unroll
            for (int r = 0; r < 16; ++r) { const float p = __builtin_amdgcn_exp2f(S[c][r] - mx); S[c][r] = p; l += p; }
        l += __shfl_xor(l, 32);
        l += __builtin_amdgcn_exp2f(sink2 - mx);
        f32x16 o0, o1;
#pragma unroll
        for (int r = 0; r < 16; ++r) { o0[r] = 0.f; o1[r] = 0.f; }
#pragma unroll
        for (int c = 0; c < 5; ++c)
#pragma unroll
            for (int s = 0; s < 2; ++s) {
                u32x4 pw; pw.x = cvtpk(S[c][8 * s + 0], S[c][8 * s + 1]); pw.y = cvtpk(S[c][8 * s + 2], S[c][8 * s + 3]); pw.z = cvtpk(S[c][8 * s + 4], S[c][8 * s + 5]); pw.w = cvtpk(S[c][8 * s + 6], S[c][8 * s + 7]);
                const bf16x8 pa = __builtin_bit_cast(bf16x8, pw);
                const int kv0 = 32 * (j + c) + 16 * s + 4 * hi;
                { const LAS unsigned char* va = lds + LDS_V + (r32 * VP + kv0) * 2;
                  const u32x2 lo = *(const LAS u32x2*)va, hh = *(const LAS u32x2*)(va + 16);
                  const u32x4 vb = {lo.x, lo.y, hh.x, hh.y};
                  o0 = __builtin_amdgcn_mfma_f32_32x32x16_bf16(pa, __builtin_bit_cast(bf16x8, vb), o0, 0, 0, 0); }
                { const LAS unsigned char* va = lds + LDS_V + ((32 + r32) * VP + kv0) * 2;
                  const u32x2 lo = *(const LAS u32x2*)va, hh = *(const LAS u32x2*)(va + 16);
                  const u32x4 vb = {lo.x, lo.y, hh.x, hh.y};
                  o1 = __builtin_amdgcn_mfma_f32_32x32x16_bf16(pa, __builtin_bit_cast(bf16x8, vb), o1, 0, 0, 0); }
            }
        if (hi == 0) wsf[r32] = __builtin_amdgcn_rcpf(l);
        asm volatile("s_waitcnt lgkmcnt(0)" ::: "memory");
#pragma unroll
        for (int r = 0; r < 16; ++r) { const int orow = crow(r, hi); const float rl = wsf[orow];
            stg[orow * 64 + r32] = (bf16_t)(cvtpk(o0[r] * rl, 0.f) & 0xffffu); stg[orow * 64 + 32 + r32] = (bf16_t)(cvtpk(o1[r] * rl, 0.f) & 0xffffu); }
        asm volatile("s_waitcnt lgkmcnt(0)" ::: "memory");
#pragma unroll
        for (int i = 0; i < 4; ++i) { const int row = i * 8 + (lane >> 3), ch = lane & 7; const u32x4 v = *(const LAS u32x4*)(stg + row * 64 + ch * 8);
            *(u32x4*)(P + (rowbase + T0 + 32 * j + row) * NP + PC_Q + h * 64 + ch * 8) = v; }
        asm volatile("s_waitcnt lgkmcnt(0)" ::: "memory");
    }
}
}

__device__ __forceinline__ void conv_pass(bf16_t* P, const float* cw, int gtid, int nthreads) {
    for (int it = gtid; it < (M / 16) * 128; it += nthreads) {
        const int c8 = (it & 127) * 8; const size_t r0 = (size_t)(it >> 7) * 16; const int t0 = (int)(r0 & (SEQ - 1));
        float w0[8], w1[8], w2[8], z1[8], z2[8];
        { const f32x4 a = *(const f32x4*)(cw + c8), b = *(const f32x4*)(cw + c8 + 4); w0[0] = a.x; w0[1] = a.y; w0[2] = a.z; w0[3] = a.w; w0[4] = b.x; w0[5] = b.y; w0[6] = b.z; w0[7] = b.w; }
        { const f32x4 a = *(const f32x4*)(cw + D + c8), b = *(const f32x4*)(cw + D + c8 + 4); w1[0] = a.x; w1[1] = a.y; w1[2] = a.z; w1[3] = a.w; w1[4] = b.x; w1[5] = b.y; w1[6] = b.z; w1[7] = b.w; }
        { const f32x4 a = *(const f32x4*)(cw + 2 * D + c8), b = *(const f32x4*)(cw + 2 * D + c8 + 4); w2[0] = a.x; w2[1] = a.y; w2[2] = a.z; w2[3] = a.w; w2[4] = b.x; w2[5] = b.y; w2[6] = b.z; w2[7] = b.w; }
        if (t0 == 0) {
#pragma unroll
            for (int e = 0; e < 8; ++e) { z1[e] = 0.f; z2[e] = 0.f; }
        } else {
            const bf16_t* pa = P + (r0 - 2) * NP + c8; const bf16_t* pb = P + (r0 - 1) * NP + c8;
            const u32x4 ca = *(const u32x4*)(pa + PC_C), va = *(const u32x4*)(pa + PC_VC), cb = *(const u32x4*)(pb + PC_C), vb = *(const u32x4*)(pb + PC_VC);
#pragma unroll
            for (int e = 0; e < 4; ++e) { z2[2 * e] = bflo(ca[e]) * bflo(va[e]); z2[2 * e + 1] = bfhi(ca[e]) * bfhi(va[e]); z1[2 * e] = bflo(cb[e]) * bflo(vb[e]); z1[2 * e + 1] = bfhi(cb[e]) * bfhi(vb[e]); }
        }
#pragma unroll 4
        for (int rr = 0; rr < 16; ++rr) {
            bf16_t* pr = P + (r0 + rr) * NP + c8;
            const u32x4 cc = *(const u32x4*)(pr + PC_C), vv = *(const u32x4*)(pr + PC_VC), bb = *(const u32x4*)(pr + PC_B);
            float z0[8], y[8];
#pragma unroll
            for (int e = 0; e < 4; ++e) { z0[2 * e] = bflo(cc[e]) * bflo(vv[e]); z0[2 * e + 1] = bfhi(cc[e]) * bfhi(vv[e]); }
#pragma unroll
            for (int e = 0; e < 8; ++e) y[e] = w0[e] * z2[e] + w1[e] * z1[e] + w2[e] * z0[e];
            u32x4 o;
#pragma unroll
            for (int e = 0; e < 4; ++e) o[e] = cvtpk(bflo(bb[e]) * y[2 * e], bfhi(bb[e]) * y[2 * e + 1]);
            *(u32x4*)(pr + PC_B) = o;
#pragma unroll
            for (int e = 0; e < 8; ++e) { z2[e] = z1[e]; z1[e] = z0[e]; }
        }
    }
}


#define XB_TMO      128
#define XB_XCNT(j)  (256  + 64 * (j))
#define XB_XSUB(j)  (1280 + 64 * (j))
#define XB_XGEN(j)  (2304 + 64 * (j))
#define XB_TOP      3328
#define XB_TOPGEN   3392
#define XCD_BAR_WORDS 3456
#define XB_SPIN_CAP (1u << 22)
__device__ __forceinline__ unsigned xb_ld(unsigned* p)              { return __hip_atomic_load(p, __ATOMIC_RELAXED, __HIP_MEMORY_SCOPE_AGENT); }
__device__ __forceinline__ unsigned xb_add(unsigned* p, unsigned v) { return __hip_atomic_fetch_add(p, v, __ATOMIC_RELAXED, __HIP_MEMORY_SCOPE_AGENT); }
__device__ __forceinline__ unsigned xb_xcc_id() { return (unsigned)__builtin_amdgcn_s_getreg((3 << 11) | 20) & 0xFu; }
#define XB_SPIN(cond, bar) do { unsigned _sp = 0; while (cond) { __builtin_amdgcn_s_sleep(1); \
    if ((++_sp & 255u) == 0u) { if (xb_ld(&(bar)[XB_TMO])) break; if (_sp > XB_SPIN_CAP) { atomicAdd(&(bar)[XB_TMO], 1u); break; } } } } while (0)
struct XcdBarrier { unsigned* bar; unsigned x; volatile LAS unsigned* st; };
__device__ __forceinline__ XcdBarrier xcd_barrier_post(unsigned* bar, volatile LAS unsigned* st) {
    XcdBarrier b; b.bar = bar; b.x = xb_xcc_id(); b.st = st;
    if (threadIdx.x == 0) (void)xb_add(&bar[XB_XCNT(b.x)], 1u);
    return b;
}
__device__ __forceinline__ void xcd_barrier_complete(unsigned* bar, unsigned x, unsigned& nloc, unsigned& nx) {
    const unsigned G = gridDim.x * gridDim.y * gridDim.z;
    unsigned sum, cnt, mine, sp = 0u;
    for (;;) {
        sum = 0u; cnt = 0u; mine = 0u;
#pragma unroll
        for (unsigned j = 0; j < 16; ++j) { const unsigned c = xb_ld(&bar[XB_XCNT(j)]); sum += c; cnt += (c > 0u) ? 1u : 0u; mine = (j == x) ? c : mine; }
        if (sum == G) break;
        __builtin_amdgcn_s_sleep(1);
        if ((++sp & 255u) == 0u) { if (xb_ld(&bar[XB_TMO])) break; if (sp > XB_SPIN_CAP) { atomicAdd(&bar[XB_TMO], 1u); break; } }
    }
    nloc = mine > 0u ? mine : 1u; nx = cnt > 0u ? cnt : 1u;
}
__device__ __forceinline__ void xcd_barrier(const XcdBarrier& b) {
    asm volatile("s_waitcnt vmcnt(0)" ::: "memory");
    __syncthreads();
    if (threadIdx.x == 0) {
        unsigned* bar = b.bar;
        __builtin_amdgcn_s_waitcnt(0);
        unsigned nloc = b.st[0], nx = b.st[1];
        if (nloc == 0u) { xcd_barrier_complete(bar, b.x, nloc, nx); b.st[0] = nloc; b.st[1] = nx; }
        const unsigned old = xb_add(&bar[XB_XSUB(b.x)], 1u);
        const unsigned gen = old / nloc;
        if (old + 1u == (gen + 1u) * nloc) {
            __builtin_amdgcn_fence(__ATOMIC_RELEASE, "agent");
            asm volatile("s_waitcnt vmcnt(0)" ::: "memory");
            const unsigned og = xb_add(&bar[XB_TOP], 1u);
            const unsigned tg = og / nx;
            if (og + 1u == (tg + 1u) * nx) xb_add(&bar[XB_TOPGEN], 1u);
            else XB_SPIN(xb_ld(&bar[XB_TOPGEN]) == tg, bar);
            __builtin_amdgcn_fence(__ATOMIC_ACQUIRE, "agent");
            xb_add(&bar[XB_XGEN(b.x)], 1u);
            asm volatile("s_waitcnt vmcnt(0)" ::: "memory");
        } else {
            XB_SPIN(xb_ld(&bar[XB_XGEN(b.x)]) == gen, bar);
            __builtin_amdgcn_fence(__ATOMIC_ACQUIRE, "agent");
            asm volatile("s_waitcnt vmcnt(0)" ::: "memory");
        }
    }
    __syncthreads();
}

struct Args { const float* in[20]; float* out; unsigned char* ws; int ph_lo, ph_hi; };
enum { I_X = 0, I_N1, I_WG1, I_WU1, I_WD1, I_NM, I_WIN, I_CONVW, I_QN, I_KN, I_SINK, I_WCO, I_WAO, I_WBG, I_BBG, I_WOUT, I_N2, I_WG2, I_WU2, I_WD2 };

__global__ void __launch_bounds__(512, 2) fwd(Args a) {
    extern __shared__ __attribute__((aligned(16))) unsigned char lds_raw[];
    LAS unsigned char* lds = (LAS unsigned char*)lds_raw;
    const int tid = threadIdx.x, lane = tid & 63, wave = __builtin_amdgcn_readfirstlane(tid >> 6);
    const int G = gridDim.x, bx = blockIdx.x;
    const int vcu = (G % 8 == 0) ? (bx % 8) * (G / 8) + bx / 8 : bx;
    unsigned char* ws = a.ws;
    bf16_t* W1 = (bf16_t*)(ws + WS_W1); bf16_t* W2 = (bf16_t*)(ws + WS_W2); bf16_t* W3 = (bf16_t*)(ws + WS_W3); bf16_t* W4 = (bf16_t*)(ws + WS_W4);
    bf16_t* W5 = (bf16_t*)(ws + WS_W5); bf16_t* W6 = (bf16_t*)(ws + WS_W6); bf16_t* W7 = (bf16_t*)(ws + WS_W7);
    float* PART1 = (float*)(ws + WS_PART1); float* PART2 = (float*)(ws + WS_PART2);
    bf16_t* XN = (bf16_t*)(ws + WS_XN); bf16_t* P = (bf16_t*)(ws + WS_P); bf16_t* X2G = (bf16_t*)(ws + WS_X2G); bf16_t* HB = (bf16_t*)(ws + WS_H);
    const int lo = a.ph_lo, hi = a.ph_hi;
#ifndef PH_MASK
#define PH_MASK 0x1ff
#endif
#define IN(k) (((PH_MASK >> (k)) & 1) && lo <= (k) && (k) < hi)
    volatile LAS unsigned* bst = (volatile LAS unsigned*)(lds + RING_BYTES + 8192);
    if (tid < 2) bst[tid] = 0u;
    __syncthreads();
#if MK_N_LAUNCHES == 1
    XcdBarrier xbar = xcd_barrier_post((unsigned*)(ws + WS_BAR), bst);
#define SEAM(k) do { if (IN(k) && IN((k) + 1)) { if ((k) == 0) cg::this_grid().sync(); else xcd_barrier(xbar); } } while (0)
#else
#define SEAM(k) do { } while (0)
#endif

    if (IN(0)) {
        LAS float* scr = (LAS float*)(lds + wave * 16384);
        const int gw = vcu * 8 + wave, NGW = G * 8;
        constexpr int NB_FF = FF / 32, IT_GU = 16 * NB_FF, IT_DN = (FF / 64) * 32, IT_IN = 16 * 136, IT_BG = 16 * 64, IT_SQ = 16 * 32;
        constexpr int NITEMS = 4 * IT_GU + 2 * IT_DN + IT_IN + IT_BG + 3 * IT_SQ;
        for (int it = gw; it < NITEMS; it += NGW) {
            int r = it;
            if (r < 4 * IT_GU) {
                const int which = r / IT_GU; r -= which * IT_GU; const int kb = r / NB_FF, nb = r % NB_FF, n0 = nb * 32;
                const float* W = a.in[which == 0 ? I_WG1 : which == 1 ? I_WU1 : which == 2 ? I_WG2 : I_WU2];
                p0_transpose_item(W, FF, (which < 2) ? W1 : W6, D, 0, 256 * (n0 >> 7) + 128 * (which & 1) + (n0 & 127), kb * 64, n0, scr, lane, (which < 2) ? nullptr : a.in[I_N2]); continue; }
            r -= 4 * IT_GU;
            if (r < 2 * IT_DN) { const int which = r / IT_DN; r -= which * IT_DN; const int kb = r / 32, nb = r % 32;
                p0_transpose_item(a.in[which ? I_WD2 : I_WD1], D, which ? W7 : W2, FF, 0, nb * 32, kb * 64, nb * 32, scr, lane); continue; }
            r -= 2 * IT_DN;
            if (r < IT_IN) { const int kb = r / 136, nb = r % 136, n0 = nb * 32;
                const int dr = n0 < 1024 ? n0 + 2048 : (n0 < 3072 ? n0 - 1024 : n0);
                p0_transpose_item(a.in[I_WIN], 4352, W3, D, 0, dr, kb * 64, n0, scr, lane, a.in[I_NM]); continue; }
            r -= IT_IN;
            if (r < IT_BG) { const int kb = r / 64, nb = r % 64; p0_transpose_item(a.in[I_WBG], 2048, W3, D, 0, PC_GC + nb * 32, kb * 64, nb * 32, scr, lane, a.in[I_NM]); continue; }
            r -= IT_BG;
            { const int which = r / IT_SQ; r -= which * IT_SQ; const int kb = r / 32, nb = r % 32;
              if (which == 0) p0_transpose_item(a.in[I_WCO], D, W4, 2048, 0, nb * 32, kb * 64, nb * 32, scr, lane);
              else if (which == 1) p0_transpose_item(a.in[I_WAO], D, W4, 2048, 1024, nb * 32, kb * 64, nb * 32, scr, lane);
              else p0_transpose_item(a.in[I_WOUT], D, W5, D, 0, nb * 32, kb * 64, nb * 32, scr, lane); }
        }
        const float* x = a.in[I_X]; const float* g1 = a.in[I_N1];
        f32x4 gv[4];
#pragma unroll
        for (int j = 0; j < 4; ++j) gv[j] = ((const f32x4*)g1)[64 * j + lane];
        for (int m0 = gw * 4; m0 < M; m0 += NGW * 4) {
            f32x4 v[4][4]; float sq[4];
#pragma unroll
            for (int r = 0; r < 4; ++r) { const f32x4* xr = (const f32x4*)(x + (size_t)(m0 + r) * D) + lane;
#pragma unroll
                for (int j = 0; j < 4; ++j) v[r][j] = xr[64 * j]; }
#pragma unroll
            for (int r = 0; r < 4; ++r) { float s = 0.f;
#pragma unroll
                for (int j = 0; j < 4; ++j) s += (v[r][j].x * v[r][j].x + v[r][j].y * v[r][j].y) + (v[r][j].z * v[r][j].z + v[r][j].w * v[r][j].w);
                sq[r] = s; }
#pragma unroll
            for (int o = 1; o < 64; o <<= 1) {
#pragma unroll
                for (int r = 0; r < 4; ++r) sq[r] += __shfl_xor(sq[r], o); }
#pragma unroll
            for (int r = 0; r < 4; ++r) { const float rstd = rsqrtf(sq[r] * (1.f / D) + EPS);
                u32x2* o8 = (u32x2*)(XN + (size_t)(m0 + r) * D) + lane;
#pragma unroll
                for (int j = 0; j < 4; ++j) { u32x2 o; o.x = cvtpk(v[r][j].x * rstd * gv[j].x, v[r][j].y * rstd * gv[j].y); o.y = cvtpk(v[r][j].z * rstd * gv[j].z, v[r][j].w * rstd * gv[j].w); o8[64 * j] = o; } }
        }
        asm volatile("s_waitcnt vmcnt(0) lgkmcnt(0)" ::: "memory"); __syncthreads();
    }
    SEAM(0);
    if (IN(1)) { pg8::Gemm g{XN, W1, D, 2 * FF, D}; pg8::StaticOrder S; S.init(M, 2 * FF, G, bx); pg8::EpiSwiglu E{HB, nullptr}; pg8::gemm_phase(lds, g, S, E); }
    SEAM(1);
    LAS float* red = (LAS float*)(lds + RING_BYTES);
    if (IN(2)) { pg8::Gemm g{HB, W2, FF, D, FF}; pg8::StaticOrder S; S.init(M, D, G, bx); pg8::EpiResid<0> E{a.in[I_X], nullptr, nullptr, XN, 0.5f, PART1, red}; pg8::gemm_phase(lds, g, S, E); }
    SEAM(2);
    if (IN(3)) { pg8::Gemm g{XN, W3, D, NP, D}; pg8::StaticOrder S; S.init(M, NP, G, bx); pg8::EpiProj E{P, PART1, a.in[I_BBG]}; pg8::gemm_phase(lds, g, S, E); }
    SEAM(3);
    if (IN(4)) {
        conv_pass(P, a.in[I_CONVW], vcu * 512 + tid, G * 512);
        {
            att::KVRegs R; int unit = vcu;
            if (unit < 1024) att::kv_load(R, P, unit, tid);
            for (; unit < 1024; unit += G) {
                att::kv_write(R, lds, a.in[I_KN], tid);
                __syncthreads();
                if (unit + G < 1024) att::kv_load(R, P, unit + G, tid);
                att::attn_compute(lds, P, a.in[I_QN], a.in[I_SINK], unit, wave, lane);
                __syncthreads();
            }
        }
        asm volatile("s_waitcnt vmcnt(0) lgkmcnt(0)" ::: "memory"); __syncthreads();
    }
    SEAM(4);
    bf16_t* MG = (bf16_t*)a.out;
    if (IN(5)) { pg8::Gemm g{P + PC_B, W4, NP, D, 2048}; pg8::StaticOrder S; S.init(M, D, G, bx); pg8::EpiMix E{P, MG}; pg8::gemm_phase(lds, g, S, E); }
    SEAM(5);
    if (IN(6)) { pg8::Gemm g{MG, W5, D, D, D}; pg8::StaticOrder S; S.init(M, D, G, bx); pg8::EpiResid<1> E{nullptr, XN, nullptr, X2G, 1.0f, PART2, red}; pg8::gemm_phase(lds, g, S, E); }
    SEAM(6);
    if (IN(7)) { pg8::Gemm g{X2G, W6, D, 2 * FF, D}; pg8::StaticOrder S; S.init(M, 2 * FF, G, bx); pg8::EpiSwiglu E{HB, PART2}; pg8::gemm_phase(lds, g, S, E); }
    SEAM(7);
    if (IN(8)) { pg8::Gemm g{HB, W7, FF, D, FF}; pg8::StaticOrder S; S.init(M, D, G, bx); pg8::EpiResid<2> E{nullptr, X2G, a.out, nullptr, 0.5f, nullptr, red}; pg8::gemm_phase(lds, g, S, E); }
#undef IN
#undef SEAM
}

extern "C" void kernel_launch(void* const* d_in, const int* in_sizes, int n_in, void* d_out, int out_size, void* d_ws, size_t ws_size, hipStream_t stream) {
    static int grid = 0;
    if (grid == 0) {
        if (n_in != 20 || in_sizes[0] != M * D || out_size != M * D || ws_size < WS_END) { fprintf(stderr, "kernel_launch: unexpected shapes (n_in %d, in0 %d, out %d, ws %zu < %zu)\n", n_in, n_in > 0 ? in_sizes[0] : -1, out_size, ws_size, (size_t)WS_END); grid = -1; return; }
        int dev = 0, cus = 0, per_cu = 0;
        hipGetDevice(&dev); hipDeviceGetAttribute(&cus, hipDeviceAttributeMultiprocessorCount, dev);
        if (hipFuncSetAttribute((const void*)fwd, hipFuncAttributeMaxDynamicSharedMemorySize, LDS_BYTES) != hipSuccess) { fprintf(stderr, "kernel_launch: hipFuncSetAttribute failed\n"); grid = -1; return; }
        hipOccupancyMaxActiveBlocksPerMultiprocessor(&per_cu, (const void*)fwd, 512, LDS_BYTES);
        (void)hipGetLastError();
        if (per_cu < 1) per_cu = 1;
        grid = cus * 1;
        fprintf(stderr, "kernel_launch: cus %d per_cu %d grid %d\n", cus, per_cu, grid);
    }
    if (grid < 0) return;
    Args a{};
    for (int i = 0; i < 20; ++i) a.in[i] = (const float*)d_in[i];
    a.out = (float*)d_out; a.ws = (unsigned char*)d_ws;
#if MK_N_LAUNCHES == 1
    (void)hipMemsetAsync((char*)d_ws + WS_BAR, 0, XCD_BAR_WORDS * 4, stream);
    a.ph_lo = 0; a.ph_hi = 9;
    void* args[] = {&a};
    hipError_t e = hipLaunchCooperativeKernel((const void*)fwd, dim3(grid), dim3(512), args, LDS_BYTES, stream);
    if (e != hipSuccess) fprintf(stderr, "cooperative launch failed: %s (grid %d)\n", hipGetErrorString(e), grid);
#else
    for (int p = 0; p < 9; ++p) { a.ph_lo = p; a.ph_hi = p + 1; hipLaunchKernelGGL(fwd, dim3(grid), dim3(512), LDS_BYTES, stream, a); }
#endif
}
```

```cpp
#include <hip/hip_runtime.h>
#include <hip/hip_cooperative_groups.h>
#include <cstdio>
#include <cstdint>
namespace cg = cooperative_groups;

#ifndef MK_N_LAUNCHES
#define MK_N_LAUNCHES 1
#endif

#define LAS __attribute__((address_space(3)))
typedef unsigned short bf16_t;
typedef short bf16x8 __attribute__((ext_vector_type(8)));
typedef float f32x4 __attribute__((ext_vector_type(4)));
typedef float f32x16 __attribute__((ext_vector_type(16)));
typedef unsigned u32x4 __attribute__((ext_vector_type(4)));
typedef unsigned u32x2 __attribute__((ext_vector_type(2)));
typedef float f32x2_t __attribute__((ext_vector_type(2)));
typedef __bf16 bf16x2_t __attribute__((ext_vector_type(2)));

constexpr int M = 65536, D = 1024, FF = 2816, SEQ = 2048;
constexpr int NP = 6400;
constexpr int PC_C = 0, PC_VC = 1024, PC_B = 2048, PC_Q = 3072, PC_K = 4096, PC_V = 4224, PC_GC = 4352, PC_GA = 5376;
constexpr float EPS = 1e-6f;
constexpr float LOG2E = 1.4426950408889634f;

constexpr size_t MiB = 1u << 20;
constexpr size_t WS_W1 = 0;
constexpr size_t WS_W2 = 11 * MiB;
constexpr size_t WS_W3 = 17 * MiB;
constexpr size_t WS_W4 = 30 * MiB;
constexpr size_t WS_W5 = 34 * MiB;
constexpr size_t WS_W6 = 36 * MiB;
constexpr size_t WS_W7 = 47 * MiB;
constexpr size_t WS_PART1 = 53 * MiB;
constexpr size_t WS_PART2 = 57 * MiB;
constexpr size_t WS_BAR = 61 * MiB;
constexpr size_t WS_XN = 64 * MiB;
constexpr size_t WS_P = 192 * MiB;
constexpr size_t WS_X2G = WS_P;
constexpr size_t WS_H = WS_P + 128 * MiB;
constexpr size_t WS_END = WS_P + 800 * MiB;

constexpr int RING_BYTES = 131072;
constexpr int LDS_BYTES = 163840;
constexpr int LDS_RED = RING_BYTES, LDS_BST = RING_BYTES + 4096, LDS_RSTD = RING_BYTES + 4160;

__device__ __forceinline__ unsigned cvtpk(float lo, float hi) { f32x2_t v = {lo, hi}; bf16x2_t b = __builtin_convertvector(v, bf16x2_t); return __builtin_bit_cast(unsigned, b); }
__device__ __forceinline__ float bflo(unsigned w) { return __uint_as_float(w << 16); }
__device__ __forceinline__ float bfhi(unsigned w) { return __uint_as_float(w & 0xffff0000u); }
__device__ __forceinline__ float sigmoidf_(float z) { return __builtin_amdgcn_rcpf(1.f + __expf(-z)); }
__device__ __forceinline__ float rstd_from_parts(const float* p) {
    const f32x4 a = *(const f32x4*)p;
    return rsqrtf(((a.x + a.y) + (a.z + a.w)) * (1.0f / 1024.0f) + EPS);
}

namespace pg8 {
constexpr int BM = 256, BK = 64, HALF = 128, HTB = HALF * BK * 2, STAGE_BYTES = 8 * HTB, NXCD = 8, WGM = 8;
__host__ __device__ __forceinline__ int lds_byte(int r, int c) { const int st = (r >> 4) * 2 + (c >> 5), rr = r & 15, cc = c & 31, ob = rr * 64 + cc * 2; return st * 1024 + (ob ^ (((ob >> 9) & 1) << 5)); }
__host__ __device__ __forceinline__ void stage_rc(int b, int& R, int& C) { const int st = b / 1024, sb = b % 1024, swz = sb ^ (((sb >> 9) & 1) << 5); R = (st >> 1) * 16 + swz / 64; C = (st & 1) * 32 + (swz % 64) / 2; }
__host__ __device__ __forceinline__ int perm32(int rho) { const int n = rho >> 4, i = rho & 15; return 8 * (i >> 2) + 4 * n + (i & 3); }

struct Unit { int pm, pn; };
struct Gemm { const bf16_t* A; const bf16_t* Bt; int lda, N, K; };

struct StaticOrder {
    int nM, nN, nwg, G, c;
    __device__ void init(int Mr, int N, int G_, int c_) { nM = Mr / BM; nN = N / BM; nwg = nM * nN; G = G_; c = c_; }
    __device__ bool next(int i, Unit& u) const {
        const long L = (long)i * G + c; if (L >= nwg) return false;
        int wgid = (int)L; { const int q = nwg / NXCD, r = nwg % NXCD, xcd = wgid % NXCD, off = wgid / NXCD; wgid = (xcd < r ? xcd * (q + 1) : r * (q + 1) + (xcd - r) * q) + off; }
        const int nig = WGM * nN, gid = wgid / nig, fm = gid * WGM, gsz = (nM - fm) < WGM ? (nM - fm) : WGM;
        u.pm = fm + ((wgid % nig) % gsz); u.pn = (wgid % nig) / gsz; return true;
    }
};

typedef f32x4 Acc[2][2][4][2];

struct EpiSwiglu {
    static constexpr bool HAS_MID = false; static constexpr int MID_T = -1;
    bf16_t* H; const LAS float* rtab;
    __device__ __forceinline__ void mid(Acc&, const Unit&, int, int, int, int) const {}
    __device__ __forceinline__ void operator()(const Acc& acc, const Unit& u, int wr, int wc, int fr, int fq, int ui) const {
        const int row0 = u.pm * BM + wr * 64 + fr, col0 = u.pn * HALF + wc * 32 + 8 * fq;
#pragma unroll
        for (int ai = 0; ai < 2; ++ai)
#pragma unroll
            for (int m = 0; m < 4; ++m) {
                const int row = row0 + ai * HALF + m * 16;
                const float rs = rtab ? rtab[ui * 256 + ai * HALF + wr * 64 + m * 16 + fr] : 1.0f;
                float h[8];
#pragma unroll
                for (int n = 0; n < 2; ++n)
#pragma unroll
                    for (int i = 0; i < 4; ++i) { const float g = acc[ai][0][m][n][i] * rs, up = acc[ai][1][m][n][i] * rs; h[4 * n + i] = g * sigmoidf_(g) * up; }
                u32x4 w; w.x = cvtpk(h[0], h[1]); w.y = cvtpk(h[2], h[3]); w.z = cvtpk(h[4], h[5]); w.w = cvtpk(h[6], h[7]);
                *(u32x4*)(H + (size_t)row * FF + col0) = w;
            }
    }
};

template <int MODE> struct EpiResid {
    static constexpr bool HAS_MID = false; static constexpr int MID_T = -1;
    const float* basef; const bf16_t* baseb; float* outf; bf16_t* outb; float alpha; float* part; LAS float* red;
    __device__ __forceinline__ void mid(Acc&, const Unit&, int, int, int, int) const {}
    __device__ __forceinline__ void operator()(const Acc& acc, const Unit& u, int wr, int wc, int fr, int fq, int ui) const {
        const int row0 = u.pm * BM + wr * 64 + fr, col0 = u.pn * BM + wc * 32 + 8 * fq;
#pragma unroll
        for (int ai = 0; ai < 2; ++ai)
#pragma unroll
            for (int m = 0; m < 4; ++m) {
                const int row = row0 + ai * HALF + m * 16; float ss = 0.f;
#pragma unroll
                for (int bj = 0; bj < 2; ++bj) {
                    const size_t off = (size_t)row * D + col0 + bj * HALF;
                    f32x4 b0, b1;
                    if (MODE == 0) { b0 = *(const f32x4*)(basef + off); b1 = *(const f32x4*)(basef + off + 4); }
                    else { const u32x4 w = *(const u32x4*)(baseb + off); b0 = (f32x4){bflo(w.x), bfhi(w.x), bflo(w.y), bfhi(w.y)}; b1 = (f32x4){bflo(w.z), bfhi(w.z), bflo(w.w), bfhi(w.w)}; }
                    const f32x4 v0 = b0 + acc[ai][bj][m][0] * alpha, v1 = b1 + acc[ai][bj][m][1] * alpha;
                    if (MODE == 2) { *(f32x4*)(outf + off) = v0; *(f32x4*)(outf + off + 4) = v1; }
                    else {
                        ss += (v0.x * v0.x + v0.y * v0.y) + (v0.z * v0.z + v0.w * v0.w) + (v1.x * v1.x + v1.y * v1.y) + (v1.z * v1.z + v1.w * v1.w);
                        u32x4 w; w.x = cvtpk(v0.x, v0.y); w.y = cvtpk(v0.z, v0.w); w.z = cvtpk(v1.x, v1.y); w.w = cvtpk(v1.z, v1.w); *(u32x4*)(outb + off) = w;
                    }
                }
                if (MODE != 2) { ss += __shfl_xor(ss, 16); ss += __shfl_xor(ss, 32); if (fq == 0) red[(ai * HALF + wr * 64 + m * 16 + fr) * 4 + wc] = ss; }
            }
        if (MODE != 2) {
            asm volatile("s_waitcnt lgkmcnt(0)" ::: "memory"); __builtin_amdgcn_s_barrier(); asm volatile("" ::: "memory");
            const int t = threadIdx.x;
            if (t < 256) { const f32x4 r = *(const LAS f32x4*)(red + t * 4); part[(size_t)(u.pm * BM + t) * 4 + u.pn] = (r.x + r.y) + (r.z + r.w); }
            asm volatile("s_waitcnt lgkmcnt(0)" ::: "memory"); __builtin_amdgcn_s_barrier(); asm volatile("" ::: "memory");
        }
    }
};

struct EpiProj {
    static constexpr bool HAS_MID = false; static constexpr int MID_T = -1;
    bf16_t* P; const LAS float* rtab; const float* bias;
    __device__ __forceinline__ void mid(Acc&, const Unit&, int, int, int, int) const {}
    __device__ __forceinline__ void operator()(const Acc& acc, const Unit& u, int wr, int wc, int fr, int fq, int ui) const {
        const int row0 = u.pm * BM + wr * 64 + fr, col0 = u.pn * BM + wc * 32 + 8 * fq; const bool gate = u.pn >= 17;
        f32x4 bv[2][2];
#pragma unroll
        for (int bj = 0; bj < 2; ++bj)
#pragma unroll
            for (int n = 0; n < 2; ++n) bv[bj][n] = gate ? *(const f32x4*)(bias + (col0 - PC_GC) + bj * HALF + 4 * n) : (f32x4){0.f, 0.f, 0.f, 0.f};
#pragma unroll
        for (int ai = 0; ai < 2; ++ai)
#pragma unroll
            for (int m = 0; m < 4; ++m) {
                const int row = row0 + ai * HALF + m * 16; const float rs = rtab[ui * 256 + ai * HALF + wr * 64 + m * 16 + fr];
#pragma unroll
                for (int bj = 0; bj < 2; ++bj) {
                    f32x4 v0 = acc[ai][bj][m][0] * rs + bv[bj][0], v1 = acc[ai][bj][m][1] * rs + bv[bj][1];
                    if (gate) { v0.x = sigmoidf_(v0.x); v0.y = sigmoidf_(v0.y); v0.z = sigmoidf_(v0.z); v0.w = sigmoidf_(v0.w); v1.x = sigmoidf_(v1.x); v1.y = sigmoidf_(v1.y); v1.z = sigmoidf_(v1.z); v1.w = sigmoidf_(v1.w); }
                    u32x4 w; w.x = cvtpk(v0.x, v0.y); w.y = cvtpk(v0.z, v0.w); w.z = cvtpk(v1.x, v1.y); w.w = cvtpk(v1.z, v1.w);
                    *(u32x4*)(P + (size_t)row * NP + col0 + bj * HALF) = w;
                }
            }
    }
};

struct EpiMix {
    static constexpr bool HAS_MID = true; static constexpr int MID_T = 16;
    const bf16_t* P; bf16_t* out;
    __device__ __forceinline__ void mid(Acc& acc, const Unit& u, int wr, int wc, int fr, int fq) const {
        int row0 = u.pm * BM + wr * 64 + fr; const int col0 = u.pn * BM + wc * 32 + 8 * fq;
        asm volatile("" : "+v"(row0));
#pragma unroll
        for (int ai = 0; ai < 2; ++ai)
#pragma unroll
            for (int m = 0; m < 4; ++m) {
                const int row = row0 + ai * HALF + m * 16;
#pragma unroll
                for (int bj = 0; bj < 2; ++bj) {
                    const bf16_t* pr = P + (size_t)row * NP + col0 + bj * HALF;
                    const u32x4 gc = *(const u32x4*)(pr + PC_GC), ga = *(const u32x4*)(pr + PC_GA);
                    f32x4 r0, r1;
                    r0.x = bflo(gc.x) * __builtin_amdgcn_rcpf(fmaxf(bflo(ga.x), 1e-30f)); r0.y = bfhi(gc.x) * __builtin_amdgcn_rcpf(fmaxf(bfhi(ga.x), 1e-30f));
                    r0.z = bflo(gc.y) * __builtin_amdgcn_rcpf(fmaxf(bflo(ga.y), 1e-30f)); r0.w = bfhi(gc.y) * __builtin_amdgcn_rcpf(fmaxf(bfhi(ga.y), 1e-30f));
                    r1.x = bflo(gc.z) * __builtin_amdgcn_rcpf(fmaxf(bflo(ga.z), 1e-30f)); r1.y = bfhi(gc.z) * __builtin_amdgcn_rcpf(fmaxf(bfhi(ga.z), 1e-30f));
                    r1.z = bflo(gc.w) * __builtin_amdgcn_rcpf(fmaxf(bflo(ga.w), 1e-30f)); r1.w = bfhi(gc.w) * __builtin_amdgcn_rcpf(fmaxf(bfhi(ga.w), 1e-30f));
                    acc[ai][bj][m][0] *= r0; acc[ai][bj][m][1] *= r1;
                }
                if (m & 1) asm volatile("" ::: "memory");
            }
    }
    __device__ __forceinline__ void operator()(const Acc& acc, const Unit& u, int wr, int wc, int fr, int fq, int ui) const {
        const int row0 = u.pm * BM + wr * 64 + fr, col0 = u.pn * BM + wc * 32 + 8 * fq;
#pragma unroll
        for (int ai = 0; ai < 2; ++ai)
#pragma unroll
            for (int m = 0; m < 4; ++m) {
                const int row = row0 + ai * HALF + m * 16;
#pragma unroll
                for (int bj = 0; bj < 2; ++bj) {
                    const u32x4 ga = *(const u32x4*)(P + (size_t)row * NP + col0 + bj * HALF + PC_GA);
                    f32x4 g0, g1;
                    g0.x = fmaxf(bflo(ga.x), 1e-30f); g0.y = fmaxf(bfhi(ga.x), 1e-30f); g0.z = fmaxf(bflo(ga.y), 1e-30f); g0.w = fmaxf(bfhi(ga.y), 1e-30f);
                    g1.x = fmaxf(bflo(ga.z), 1e-30f); g1.y = fmaxf(bfhi(ga.z), 1e-30f); g1.z = fmaxf(bflo(ga.w), 1e-30f); g1.w = fmaxf(bfhi(ga.w), 1e-30f);
                    const f32x4 v0 = acc[ai][bj][m][0] * g0, v1 = acc[ai][bj][m][1] * g1;
                    u32x4 w; w.x = cvtpk(v0.x, v0.y); w.y = cvtpk(v0.z, v0.w); w.z = cvtpk(v1.x, v1.y); w.w = cvtpk(v1.z, v1.w);
                    *(u32x4*)(out + (size_t)row * D + col0 + bj * HALF) = w;
                }
            }
    }
};

template <class Epi>
__device__ __forceinline__ void gemm_phase(LAS unsigned char* lds, const Gemm g, const StaticOrder& S, const Epi& E) {
    const int tid = threadIdx.x, wid = __builtin_amdgcn_readfirstlane(tid >> 6), lane = tid & 63, wr = wid >> 2, wc = wid & 3, fr = lane & 15, fq = lane >> 4;
    const int K = g.K, nt = K / BK, lda = g.lda;
    unsigned voffA[2], voffB[2];
#pragma unroll
    for (int i = 0; i < 2; ++i) { int R, C; stage_rc(tid * 16 + i * 8192, R, C); const int Rb = (R & ~31) + perm32(R & 31);
        voffA[i] = (unsigned)(R * lda + C) * 2u; voffB[i] = (unsigned)(Rb * K + C) * 2u; }
    const size_t kstep = (size_t)(BK * 2);
    const size_t hstepA = (size_t)HALF * lda * 2, hstepB = (size_t)HALF * K * 2;
    const size_t tstepA = 2 * hstepA, tstepB = 2 * hstepB;
    const unsigned ldsw = (unsigned)wid * 1024u;
    const int aoff = lds_byte(wr * 64 + fr, fq * 8), boff = lds_byte(wc * 32 + fr, fq * 8);
#define PG8_SA(b, h) (((b) * 2 + (h)) * HTB)
#define PG8_SB(b, h) ((4 + (b) * 2 + (h)) * HTB)
#define PG8_STAGE(bufoff, gbase, voff) do { _Pragma("unroll") for (int _i = 0; _i < 2; ++_i) \
        __builtin_amdgcn_global_load_lds((const unsigned*)((const char*)(gbase) + (voff)[_i]), (LAS unsigned*)(lds + (bufoff) + ldsw + _i * 8192), 16, 0, 0); } while (0)
#define PG8_LDA(dst, b, h) do { _Pragma("unroll") for (int m = 0; m < 4; ++m) _Pragma("unroll") for (int k = 0; k < 2; ++k) dst[m][k] = *(const LAS bf16x8*)(lds + PG8_SA(b, h) + aoff + m * 2048 + k * 1024); } while (0)
#define PG8_LDB(dst, b, h) do { _Pragma("unroll") for (int n = 0; n < 2; ++n) _Pragma("unroll") for (int k = 0; k < 2; ++k) dst[n][k] = *(const LAS bf16x8*)(lds + PG8_SB(b, h) + boff + n * 2048 + k * 1024); } while (0)
#define PG8_MMA(ai, bj, At, Bt) do { __builtin_amdgcn_s_setprio(1); _Pragma("unroll") for (int m = 0; m < 4; ++m) _Pragma("unroll") for (int n = 0; n < 2; ++n) _Pragma("unroll") for (int k = 0; k < 2; ++k) \
        acc[ai][bj][m][n] = __builtin_amdgcn_mfma_f32_16x16x32_bf16(Bt[n][k], At[m][k], acc[ai][bj][m][n], 0, 0, 0); __builtin_amdgcn_s_setprio(0); } while (0)
#define PG8_WAIT_V(n) asm volatile("s_waitcnt vmcnt(" #n ")" ::: "memory")
#define PG8_WAIT_L(n) asm volatile("s_waitcnt lgkmcnt(" #n ")" ::: "memory")
#define PG8_BAR __builtin_amdgcn_s_barrier()
#define PG8_SCHED __builtin_amdgcn_sched_barrier(0)
    Unit cur, nxt; int ui = 0;
    if (!S.next(0, cur)) return;
    Acc acc;
#pragma unroll
    for (int a = 0; a < 2; ++a)
#pragma unroll
        for (int b = 0; b < 2; ++b)
#pragma unroll
            for (int m = 0; m < 4; ++m)
#pragma unroll
                for (int n = 0; n < 2; ++n) acc[a][b][m][n] = (f32x4){0.f, 0.f, 0.f, 0.f};
    bf16x8 At[4][2], B0[2][2], B1[2][2];
    const char* cA = (const char*)g.A + (size_t)cur.pm * tstepA; const char* cB = (const char*)g.Bt + (size_t)cur.pn * tstepB;
    PG8_STAGE(PG8_SB(0, 0), cB, voffB); PG8_STAGE(PG8_SB(0, 1), cB + hstepB, voffB); PG8_STAGE(PG8_SA(0, 0), cA, voffA); PG8_STAGE(PG8_SA(0, 1), cA + hstepA, voffA);
    if (wr == 1) PG8_BAR;
    PG8_WAIT_V(2); PG8_BAR;
    PG8_STAGE(PG8_SB(1, 0), cB + kstep, voffB); PG8_STAGE(PG8_SA(1, 0), cA + kstep, voffA); PG8_STAGE(PG8_SB(1, 1), cB + hstepB + kstep, voffB);
    PG8_WAIT_V(6); PG8_BAR;
    for (;;) {
        const bool has_next = S.next(ui + 1, nxt);
        const char* nA = has_next ? (const char*)g.A + (size_t)nxt.pm * tstepA : cA; const char* nB = has_next ? (const char*)g.Bt + (size_t)nxt.pn * tstepB : cB;
        for (int t = 0; t < nt; t += 2) {
            if constexpr (Epi::HAS_MID) { if (t == Epi::MID_T) { E.mid(acc, cur, wr, wc, fr, fq); PG8_SCHED; } }
            const bool last = (t == nt - 2);
            const char* a1 = cA + (size_t)(t + 1) * kstep;
            const char* a2 = last ? nA : cA + (size_t)(t + 2) * kstep; const char* b2 = last ? nB : cB + (size_t)(t + 2) * kstep;
            const char* a3 = a2 + kstep; const char* b3 = b2 + kstep;
            PG8_LDB(B0, 0, 0); PG8_LDB(B1, 0, 1); PG8_SCHED; PG8_LDA(At, 0, 0); PG8_STAGE(PG8_SA(1, 1), a1 + hstepA, voffA);
            PG8_WAIT_V(8); PG8_WAIT_L(0); PG8_BAR; PG8_MMA(0, 0, At, B0); PG8_MMA(0, 1, At, B1); PG8_BAR; PG8_SCHED;
            PG8_LDA(At, 0, 1); PG8_STAGE(PG8_SB(0, 0), b2, voffB); PG8_STAGE(PG8_SB(0, 1), b2 + hstepB, voffB); PG8_STAGE(PG8_SA(0, 0), a2, voffA);
            PG8_WAIT_V(8); PG8_WAIT_L(0); PG8_BAR; PG8_MMA(1, 0, At, B0); PG8_MMA(1, 1, At, B1); PG8_BAR; PG8_SCHED;
            PG8_LDB(B0, 1, 0); PG8_LDB(B1, 1, 1); PG8_SCHED; PG8_LDA(At, 1, 0); PG8_STAGE(PG8_SA(0, 1), a2 + hstepA, voffA);
            PG8_WAIT_V(8); PG8_WAIT_L(0); PG8_BAR; PG8_MMA(0, 0, At, B0); PG8_MMA(0, 1, At, B1); PG8_BAR; PG8_SCHED;
            PG8_LDA(At, 1, 1); PG8_STAGE(PG8_SB(1, 0), b3, voffB); PG8_STAGE(PG8_SB(1, 1), b3 + hstepB, voffB); PG8_STAGE(PG8_SA(1, 0), a3, voffA);
            PG8_WAIT_V(8); PG8_WAIT_L(0); PG8_BAR; PG8_MMA(1, 0, At, B0); PG8_MMA(1, 1, At, B1); PG8_BAR; PG8_SCHED;
        }
        if (wr == 0) PG8_BAR;
        E(acc, cur, wr, wc, fr, fq, ui);
        if (!has_next) break;
#pragma unroll
        for (int a = 0; a < 2; ++a)
#pragma unroll
            for (int b = 0; b < 2; ++b)
#pragma unroll
                for (int m = 0; m < 4; ++m)
#pragma unroll
                    for (int n = 0; n < 2; ++n) acc[a][b][m][n] = (f32x4){0.f, 0.f, 0.f, 0.f};
        cur = nxt; cA = nA; cB = nB; ++ui;
        if (wr == 1) PG8_BAR;
    }
    PG8_WAIT_V(0);
    PG8_BAR;
#undef PG8_SA
#undef PG8_SB
#undef PG8_STAGE
#undef PG8_LDA
#undef PG8_LDB
#undef PG8_MMA
#undef PG8_WAIT_V
#undef PG8_WAIT_L
#undef PG8_BAR
#undef PG8_SCHED
}
}

__device__ __forceinline__ float wave_sum(float v) {
#pragma unroll
    for (int o = 1; o < 64; o <<= 1) v += __shfl_xor(v, o);
    return v;
}
__device__ __forceinline__ void p0_transpose_item(const float* W, int N, bf16_t* WT, int ldk, int koff, int drow0, int k0, int n0, LAS float* scr, int lane, const float* ksc = nullptr) {
#pragma unroll 8
    for (int i = 0; i < 32; ++i) { const int kk = 2 * i + (lane >> 5); const float sc = ksc ? ksc[k0 + kk] : 1.0f; scr[kk * 33 + (lane & 31)] = W[(size_t)(k0 + kk) * N + n0 + (lane & 31)] * sc; }
    asm volatile("s_waitcnt lgkmcnt(0)" ::: "memory");
    const int c = lane & 7;
#pragma unroll
    for (int j = 0; j < 4; ++j) { const int n = (lane >> 3) + 8 * j; const LAS float* s = scr + (8 * c) * 33 + n;
        u32x4 o; o.x = cvtpk(s[0 * 33], s[1 * 33]); o.y = cvtpk(s[2 * 33], s[3 * 33]); o.z = cvtpk(s[4 * 33], s[5 * 33]); o.w = cvtpk(s[6 * 33], s[7 * 33]);
        *(u32x4*)(WT + (size_t)(drow0 + n) * ldk + koff + k0 + 8 * c) = o; }
    asm volatile("s_waitcnt lgkmcnt(0)" ::: "memory");
}

namespace att {
constexpr int KPB = 144;
constexpr int VP = 260;
constexpr int LDS_K = 0, LDS_V = 36864, LDS_WS = 70144, LDS_OST = 72192, LDS_END = 104960;
__device__ __forceinline__ int crow(int r, int hi) { return (r & 3) + 8 * (r >> 2) + 4 * hi; }

struct KVRegs { u32x4 kr[4], vr[4]; };
__device__ __forceinline__ void kv_load(KVRegs& R, const bf16_t* P, int unit, int tid) {
    const int hk = unit & 1, n = (unit >> 1) & 15, b = unit >> 5;
    const int kk = tid >> 1, half = tid & 1; const int kp = n * 128 - 128 + kk;
    if (kp >= 0) { const bf16_t* pr = P + ((size_t)b * SEQ + kp) * NP + PC_K + hk * 64 + half * 32;
#pragma unroll
        for (int i = 0; i < 4; ++i) { R.kr[i] = *(const u32x4*)(pr + 8 * i); R.vr[i] = *(const u32x4*)(pr + 128 + 8 * i); } }
    else {
#pragma unroll
        for (int i = 0; i < 4; ++i) { R.kr[i] = (u32x4){0u, 0u, 0u, 0u}; R.vr[i] = (u32x4){0u, 0u, 0u, 0u}; } }
}
__device__ __forceinline__ void kv_write(const KVRegs& R, LAS unsigned char* lds, const float* kn_w, int tid) {
    const int kk = tid >> 1, half = tid & 1;
    float ss = 0.f;
#pragma unroll
    for (int i = 0; i < 4; ++i)
#pragma unroll
        for (int e = 0; e < 4; ++e) { const float a = bflo(R.kr[i][e]), c = bfhi(R.kr[i][e]); ss += a * a + c * c; }
    ss += __shfl_xor(ss, 1);
    const float rs = rsqrtf(ss * (1.0f / 64.0f) + EPS);
#pragma unroll
    for (int i = 0; i < 4; ++i) {
        const f32x4 w0 = *(const f32x4*)(kn_w + half * 32 + 8 * i), w1 = *(const f32x4*)(kn_w + half * 32 + 8 * i + 4);
        u32x4 o;
        o.x = cvtpk(bflo(R.kr[i].x) * rs * w0.x, bfhi(R.kr[i].x) * rs * w0.y); o.y = cvtpk(bflo(R.kr[i].y) * rs * w0.z, bfhi(R.kr[i].y) * rs * w0.w);
        o.z = cvtpk(bflo(R.kr[i].z) * rs * w1.x, bfhi(R.kr[i].z) * rs * w1.y); o.w = cvtpk(bflo(R.kr[i].w) * rs * w1.z, bfhi(R.kr[i].w) * rs * w1.w);
        *(LAS u32x4*)(lds + LDS_K + kk * KPB + half * 64 + 16 * i) = o;
    }
#pragma unroll
    for (int i = 0; i < 4; ++i)
#pragma unroll
        for (int e = 0; e < 8; ++e) {
            const unsigned short val = (unsigned short)((R.vr[i][e >> 1] >> (16 * (e & 1))) & 0xffffu);
            *(LAS unsigned short*)(lds + LDS_V + ((half * 32 + 8 * i + e) * VP + kk) * 2) = val;
        }
}
__device__ __forceinline__ void attn_compute(LAS unsigned char* lds, bf16_t* P, const float* qn_w, const float* sinks, int unit, int wid, int lane) {
    const int hk = unit & 1, n = (unit >> 1) & 15, b = unit >> 5;
    const int T0 = n * 128; const size_t rowbase = (size_t)b * SEQ;
    const int h = hk * 8 + wid, r32 = lane & 31, hi = lane >> 5;
    const float sink2 = sinks[h] * LOG2E;
    LAS float* wsf = (LAS float*)(lds + LDS_WS) + wid * 64;
    LAS bf16_t* stg = (LAS bf16_t*)(lds + LDS_OST) + wid * 2048;
    const float NEG = -1e30f;
    u32x4 qnext[4];
    { const bf16_t* qp = P + (rowbase + T0 + r32) * NP + PC_Q + h * 64;
#pragma unroll
      for (int d0 = 0; d0 < 4; ++d0) qnext[d0] = *(const u32x4*)(qp + 16 * d0 + 8 * hi); }
#pragma unroll 1
    for (int j = 0; j < 4; ++j) {
        u32x4 qraw[4]; float ss = 0.f;
#pragma unroll
        for (int d0 = 0; d0 < 4; ++d0) { qraw[d0] = qnext[d0];
#pragma unroll
            for (int e = 0; e < 4; ++e) { const float a = bflo(qraw[d0][e]), c = bfhi(qraw[d0][e]); ss += a * a + c * c; } }
        if (j < 3) { const bf16_t* qp = P + (rowbase + T0 + 32 * (j + 1) + r32) * NP + PC_Q + h * 64;
#pragma unroll
            for (int d0 = 0; d0 < 4; ++d0) qnext[d0] = *(const u32x4*)(qp + 16 * d0 + 8 * hi); }
        ss += __shfl_xor(ss, 32);
        const float rs = rsqrtf(ss * (1.0f / 64.0f) + EPS) * (0.125f * LOG2E);
        bf16x8 qr[4];
#pragma unroll
        for (int d0 = 0; d0 < 4; ++d0) {
            const f32x4 w0 = *(const f32x4*)(qn_w + 16 * d0 + 8 * hi), w1 = *(const f32x4*)(qn_w + 16 * d0 + 8 * hi + 4);
            u32x4 o;
            o.x = cvtpk(bflo(qraw[d0].x) * rs * w0.x, bfhi(qraw[d0].x) * rs * w0.y); o.y = cvtpk(bflo(qraw[d0].y) * rs * w0.z, bfhi(qraw[d0].y) * rs * w0.w);
            o.z = cvtpk(bflo(qraw[d0].z) * rs * w1.x, bfhi(qraw[d0].z) * rs * w1.y); o.w = cvtpk(bflo(qraw[d0].w) * rs * w1.z, bfhi(qraw[d0].w) * rs * w1.w);
            qr[d0] = __builtin_bit_cast(bf16x8, o);
        }
        f32x16 S[5];
#pragma unroll
        for (int c = 0; c < 5; ++c) {
            f32x16 p;
#pragma unroll
            for (int r = 0; r < 16; ++r) p[r] = 0.f;
#pragma unroll
            for (int d0 = 0; d0 < 4; ++d0) {
                const bf16x8 kf = *(const LAS bf16x8*)(lds + LDS_K + (32 * (j + c) + r32) * KPB + (16 * d0 + 8 * hi) * 2);
                p = __builtin_amdgcn_mfma_f32_32x32x16_bf16(kf, qr[d0], p, 0, 0, 0);
            }
            S[c] = p;
        }
#pragma unroll
        for (int r = 0; r < 16; ++r) { const int kl = crow(r, hi); if (!(kl > r32)) S[0][r] = NEG; if (!(kl <= r32)) S[4][r] = NEG; }
        if (n == 0) {
#pragma unroll
            for (int c = 0; c < 5; ++c) if (j + c < 4) {
#pragma unroll
                for (int r = 0; r < 16; ++r) S[c][r] = NEG; }
        }
        float mx = sink2;
#pragma unroll
        for (int c = 0; c < 5; ++c)
#pragma unroll
            for (int r = 0; r < 16; ++r) mx = fmaxf(mx, S[c][r]);
        mx = fmaxf(mx, __shfl_xor(mx, 32));
        float l = 0.f;
#pragma unroll
        for (int c = 0; c < 5; ++c)
#pragma unroll
            for (int r = 0; r < 16; ++r) { const float p = __builtin_amdgcn_exp2f(S[c][r] - mx); S[c][r] = p; l += p; }
        l += __shfl_xor(l, 32);
        l += __builtin_amdgcn_exp2f(sink2 - mx);
        f32x16 o0, o1;
#pragma unroll
        for (int r = 0; r < 16; ++r) { o0[r] = 0.f; o1[r] = 0.f; }
#pragma unroll
        for (int c = 0; c < 5; ++c)
#pragma unroll
            for (int s = 0; s < 2; ++s) {
                u32x4 pw; pw.x = cvtpk(S[c][8 * s + 0], S[c][8 * s + 1]); pw.y = cvtpk(S[c][8 * s + 2], S[c][8 * s + 3]); pw.z = cvtpk(S[c][8 * s + 4], S[c][8 * s + 5]); pw.w = cvtpk(S[c][8 * s + 6], S[c][8 * s + 7]);
                const bf16x8 pa = __builtin_bit_cast(bf16x8, pw);
                const int kv0 = 32 * (j + c) + 16 * s + 4 * hi;
                { const LAS unsigned char* va = lds + LDS_V + (r32 * VP + kv0) * 2;
                  const u32x2 lo = *(const LAS u32x2*)va, hh = *(const LAS u32x2*)(va + 16);
                  const u32x4 vb = {lo.x, lo.y, hh.x, hh.y};
                  o0 = __builtin_amdgcn_mfma_f32_32x32x16_bf16(pa, __builtin_bit_cast(bf16x8, vb), o0, 0, 0, 0); }
                { const LAS unsigned char* va = lds + LDS_V + ((32 + r32) * VP + kv0) * 2;
                  const u32x2 lo = *(const LAS u32x2*)va, hh = *(const LAS u32x2*)(va + 16);
                  const u32x4 vb = {lo.x, lo.y, hh.x, hh.y};
                  o1 = __builtin_amdgcn_mfma_f32_32x32x16_bf16(pa, __builtin_bit_cast(bf16x8, vb), o1, 0, 0, 0); }
            }
        if (hi == 0) wsf[r32] = __builtin_amdgcn_rcpf(l);
        asm volatile("s_waitcnt lgkmcnt(0)" ::: "memory");
#pragma unroll
        for (int r = 0; r < 16; ++r) { const int orow = crow(r, hi); const float rl = wsf[orow];
            stg[orow * 64 + r32] = (bf16_t)(cvtpk(o0[r] * rl, 0.f) & 0xffffu); stg[orow * 64 + 32 + r32] = (bf16_t)(cvtpk(o1[r] * rl, 0.f) & 0xffffu); }
        asm volatile("s_waitcnt lgkmcnt(0)" ::: "memory");
#pragma unroll
        for (int i = 0; i < 4; ++i) { const int row = i * 8 + (lane >> 3), ch = lane & 7; const u32x4 v = *(const LAS u32x4*)(stg + row * 64 + ch * 8);
            *(u32x4*)(P + (rowbase + T0 + 32 * j + row) * NP + PC_Q + h * 64 + ch * 8) = v; }
        asm volatile("s_waitcnt lgkmcnt(0)" ::: "memory");
    }
}
}

__device__ __forceinline__ void conv_pass(bf16_t* P, const float* cw, int gtid, int nthreads) {
    for (int it = gtid; it < (M / 16) * 128; it += nthreads) {
        const int c8 = (it & 127) * 8; const size_t r0 = (size_t)(it >> 7) * 16; const int t0 = (int)(r0 & (SEQ - 1));
        float w0[8], w1[8], w2[8], z1[8], z2[8];
        { const f32x4 a = *(const f32x4*)(cw + c8), b = *(const f32x4*)(cw + c8 + 4); w0[0] = a.x; w0[1] = a.y; w0[2] = a.z; w0[3] = a.w; w0[4] = b.x; w0[5] = b.y; w0[6] = b.z; w0[7] = b.w; }
        { const f32x4 a = *(const f32x4*)(cw + D + c8), b = *(const f32x4*)(cw + D + c8 + 4); w1[0] = a.x; w1[1] = a.y; w1[2] = a.z; w1[3] = a.w; w1[4] = b.x; w1[5] = b.y; w1[6] = b.z; w1[7] = b.w; }
        { const f32x4 a = *(const f32x4*)(cw + 2 * D + c8), b = *(const f32x4*)(cw + 2 * D + c8 + 4); w2[0] = a.x; w2[1] = a.y; w2[2] = a.z; w2[3] = a.w; w2[4] = b.x; w2[5] = b.y; w2[6] = b.z; w2[7] = b.w; }
        if (t0 == 0) {
#pragma unroll
            for (int e = 0; e < 8; ++e) { z1[e] = 0.f; z2[e] = 0.f; }
        } else {
            const bf16_t* pa = P + (r0 - 2) * NP + c8; const bf16_t* pb = P + (r0 - 1) * NP + c8;
            const u32x4 ca = *(const u32x4*)(pa + PC_C), va = *(const u32x4*)(pa + PC_VC), cb = *(const u32x4*)(pb + PC_C), vb = *(const u32x4*)(pb + PC_VC);
#pragma unroll
            for (int e = 0; e < 4; ++e) { z2[2 * e] = bflo(ca[e]) * bflo(va[e]); z2[2 * e + 1] = bfhi(ca[e]) * bfhi(va[e]); z1[2 * e] = bflo(cb[e]) * bflo(vb[e]); z1[2 * e + 1] = bfhi(cb[e]) * bfhi(vb[e]); }
        }
#pragma unroll 4
        for (int rr = 0; rr < 16; ++rr) {
            bf16_t* pr = P + (r0 + rr) * NP + c8;
            const u32x4 cc = *(const u32x4*)(pr + PC_C), vv = *(const u32x4*)(pr + PC_VC), bb = *(const u32x4*)(pr + PC_B);
            float z0[8], y[8];
#pragma unroll
            for (int e = 0; e < 4; ++e) { z0[2 * e] = bflo(cc[e]) * bflo(vv[e]); z0[2 * e + 1] = bfhi(cc[e]) * bfhi(vv[e]); }
#pragma unroll
            for (int e = 0; e < 8; ++e) y[e] = w0[e] * z2[e] + w1[e] * z1[e] + w2[e] * z0[e];
            u32x4 o;
#pragma unroll
            for (int e = 0; e < 4; ++e) o[e] = cvtpk(bflo(bb[e]) * y[2 * e], bfhi(bb[e]) * y[2 * e + 1]);
            *(u32x4*)(pr + PC_B) = o;
#pragma unroll
            for (int e = 0; e < 8; ++e) { z2[e] = z1[e]; z1[e] = z0[e]; }
        }
    }
}


#define XB_TMO      128
#define XB_XCNT(j)  (256  + 64 * (j))
#define XB_XSUB(j)  (1280 + 64 * (j))
#define XB_XGEN(j)  (2304 + 64 * (j))
#define XB_TOP      3328
#define XB_TOPGEN   3392
#define XCD_BAR_WORDS 3456
#define XB_SPIN_CAP (1u << 22)
__device__ __forceinline__ unsigned xb_ld(unsigned* p)              { return __hip_atomic_load(p, __ATOMIC_RELAXED, __HIP_MEMORY_SCOPE_AGENT); }
__device__ __forceinline__ unsigned xb_add(unsigned* p, unsigned v) { return __hip_atomic_fetch_add(p, v, __ATOMIC_RELAXED, __HIP_MEMORY_SCOPE_AGENT); }
__device__ __forceinline__ unsigned xb_xcc_id() { return (unsigned)__builtin_amdgcn_s_getreg((3 << 11) | 20) & 0xFu; }
#define XB_SPIN(cond, bar) do { unsigned _sp = 0; while (cond) { __builtin_amdgcn_s_sleep(1); \
    if ((++_sp & 255u) == 0u) { if (xb_ld(&(bar)[XB_TMO])) break; if (_sp > XB_SPIN_CAP) { atomicAdd(&(bar)[XB_TMO], 1u); break; } } } } while (0)
struct XcdBarrier { unsigned* bar; unsigned x; volatile LAS unsigned* st; };
__device__ __forceinline__ XcdBarrier xcd_barrier_post(unsigned* bar, volatile LAS unsigned* st) {
    XcdBarrier b; b.bar = bar; b.x = xb_xcc_id(); b.st = st;
    if (threadIdx.x == 0) (void)xb_add(&bar[XB_XCNT(b.x)], 1u);
    return b;
}
__device__ __forceinline__ void xcd_barrier_complete(unsigned* bar, unsigned x, unsigned& nloc, unsigned& nx) {
    const unsigned G = gridDim.x * gridDim.y * gridDim.z;
    unsigned sum, cnt, mine, sp = 0u;
    for (;;) {
        sum = 0u; cnt = 0u; mine = 0u;
#pragma unroll
        for (unsigned j = 0; j < 16; ++j) { const unsigned c = xb_ld(&bar[XB_XCNT(j)]); sum += c; cnt += (c > 0u) ? 1u : 0u; mine = (j == x) ? c : mine; }
        if (sum == G) break;
        __builtin_amdgcn_s_sleep(1);
        if ((++sp & 255u) == 0u) { if (xb_ld(&bar[XB_TMO])) break; if (sp > XB_SPIN_CAP) { atomicAdd(&bar[XB_TMO], 1u); break; } }
    }
    nloc = mine > 0u ? mine : 1u; nx = cnt > 0u ? cnt : 1u;
}
__device__ __forceinline__ void xcd_barrier(const XcdBarrier& b) {
    asm volatile("s_waitcnt vmcnt(0)" ::: "memory");
    __syncthreads();
    if (threadIdx.x == 0) {
        unsigned* bar = b.bar;
        __builtin_amdgcn_s_waitcnt(0);
        unsigned nloc = b.st[0], nx = b.st[1];
        if (nloc == 0u) { xcd_barrier_complete(bar, b.x, nloc, nx); b.st[0] = nloc; b.st[1] = nx; }
        const unsigned old = xb_add(&bar[XB_XSUB(b.x)], 1u);
        const unsigned gen = old / nloc;
        if (old + 1u == (gen + 1u) * nloc) {
            __builtin_amdgcn_fence(__ATOMIC_RELEASE, "agent");
            asm volatile("s_waitcnt vmcnt(0)" ::: "memory");
            const unsigned og = xb_add(&bar[XB_TOP], 1u);
            const unsigned tg = og / nx;
            if (og + 1u == (tg + 1u) * nx) xb_add(&bar[XB_TOPGEN], 1u);
            else XB_SPIN(xb_ld(&bar[XB_TOPGEN]) == tg, bar);
            __builtin_amdgcn_fence(__ATOMIC_ACQUIRE, "agent");
            xb_add(&bar[XB_XGEN(b.x)], 1u);
            asm volatile("s_waitcnt vmcnt(0)" ::: "memory");
        } else {
            XB_SPIN(xb_ld(&bar[XB_XGEN(b.x)]) == gen, bar);
            __builtin_amdgcn_fence(__ATOMIC_ACQUIRE, "agent");
            asm volatile("s_waitcnt vmcnt(0)" ::: "memory");
        }
    }
    __syncthreads();
}

__device__ __forceinline__ void rstd_prepass(const pg8::StaticOrder& S, const float* part, LAS float* tab, int tid) {
    if (tid < 256) {
        for (int i0 = 0; i0 < 32; i0 += 8) {
            f32x4 v[8]; bool ok[8];
#pragma unroll
            for (int j = 0; j < 8; ++j) { pg8::Unit u; ok[j] = S.next(i0 + j, u); v[j] = ok[j] ? *(const f32x4*)(part + (size_t)(u.pm * 256 + tid) * 4) : (f32x4){0.f, 0.f, 0.f, 0.f}; }
#pragma unroll
            for (int j = 0; j < 8; ++j) if (ok[j] && (i0 + j) < 25) tab[(i0 + j) * 256 + tid] = rsqrtf(((v[j].x + v[j].y) + (v[j].z + v[j].w)) * (1.0f / 1024.0f) + EPS);
        }
    }
    asm volatile("s_waitcnt vmcnt(0) lgkmcnt(0)" ::: "memory"); __syncthreads();
}

struct Args { const float* in[20]; float* out; unsigned char* ws; int ph_lo, ph_hi; };
enum { I_X = 0, I_N1, I_WG1, I_WU1, I_WD1, I_NM, I_WIN, I_CONVW, I_QN, I_KN, I_SINK, I_WCO, I_WAO, I_WBG, I_BBG, I_WOUT, I_N2, I_WG2, I_WU2, I_WD2 };

__global__ void __launch_bounds__(512, 2) fwd(Args a) {
    extern __shared__ __attribute__((aligned(16))) unsigned char lds_raw[];
    LAS unsigned char* lds = (LAS unsigned char*)lds_raw;
    const int tid = threadIdx.x, lane = tid & 63, wave = __builtin_amdgcn_readfirstlane(tid >> 6);
    const int G = gridDim.x, bx = blockIdx.x;
    const int vcu = (G % 8 == 0) ? (bx % 8) * (G / 8) + bx / 8 : bx;
    unsigned char* ws = a.ws;
    bf16_t* W1 = (bf16_t*)(ws + WS_W1); bf16_t* W2 = (bf16_t*)(ws + WS_W2); bf16_t* W3 = (bf16_t*)(ws + WS_W3); bf16_t* W4 = (bf16_t*)(ws + WS_W4);
    bf16_t* W5 = (bf16_t*)(ws + WS_W5); bf16_t* W6 = (bf16_t*)(ws + WS_W6); bf16_t* W7 = (bf16_t*)(ws + WS_W7);
    float* PART1 = (float*)(ws + WS_PART1); float* PART2 = (float*)(ws + WS_PART2);
    bf16_t* XN = (bf16_t*)(ws + WS_XN); bf16_t* P = (bf16_t*)(ws + WS_P); bf16_t* X2G = (bf16_t*)(ws + WS_X2G); bf16_t* HB = (bf16_t*)(ws + WS_H);
    const int lo = a.ph_lo, hi = a.ph_hi;
#ifndef PH_MASK
#define PH_MASK 0x1ff
#endif
#define IN(k) (((PH_MASK >> (k)) & 1) && lo <= (k) && (k) < hi)
    volatile LAS unsigned* bst = (volatile LAS unsigned*)(lds + LDS_BST);
    if (tid < 2) bst[tid] = 0u;
    __syncthreads();
#if MK_N_LAUNCHES == 1
    XcdBarrier xbar = xcd_barrier_post((unsigned*)(ws + WS_BAR), bst);
    if (a.ph_lo < 0) cg::this_grid().sync();
#define SEAM(k) do { if (IN(k) && IN((k) + 1)) xcd_barrier(xbar); } while (0)
#else
#define SEAM(k) do { } while (0)
#endif

    if (IN(0)) {
        LAS float* scr = (LAS float*)(lds + wave * 16384);
        const int gw = vcu * 8 + wave, NGW = G * 8;
        constexpr int NB_FF = FF / 32, IT_GU = 16 * NB_FF, IT_DN = (FF / 64) * 32, IT_IN = 16 * 136, IT_BG = 16 * 64, IT_SQ = 16 * 32;
        constexpr int NITEMS = 4 * IT_GU + 2 * IT_DN + IT_IN + IT_BG + 3 * IT_SQ;
        for (int it = gw; it < NITEMS; it += NGW) {
            int r = it;
            if (r < 4 * IT_GU) {
                const int which = r / IT_GU; r -= which * IT_GU; const int kb = r / NB_FF, nb = r % NB_FF, n0 = nb * 32;
                const float* W = a.in[which == 0 ? I_WG1 : which == 1 ? I_WU1 : which == 2 ? I_WG2 : I_WU2];
                p0_transpose_item(W, FF, (which < 2) ? W1 : W6, D, 0, 256 * (n0 >> 7) + 128 * (which & 1) + (n0 & 127), kb * 64, n0, scr, lane, (which < 2) ? nullptr : a.in[I_N2]); continue; }
            r -= 4 * IT_GU;
            if (r < 2 * IT_DN) { const int which = r / IT_DN; r -= which * IT_DN; const int kb = r / 32, nb = r % 32;
                p0_transpose_item(a.in[which ? I_WD2 : I_WD1], D, which ? W7 : W2, FF, 0, nb * 32, kb * 64, nb * 32, scr, lane); continue; }
            r -= 2 * IT_DN;
            if (r < IT_IN) { const int kb = r / 136, nb = r % 136, n0 = nb * 32;
                const int dr = n0 < 1024 ? n0 + 2048 : (n0 < 3072 ? n0 - 1024 : n0);
                p0_transpose_item(a.in[I_WIN], 4352, W3, D, 0, dr, kb * 64, n0, scr, lane, a.in[I_NM]); continue; }
            r -= IT_IN;
            if (r < IT_BG) { const int kb = r / 64, nb = r % 64; p0_transpose_item(a.in[I_WBG], 2048, W3, D, 0, PC_GC + nb * 32, kb * 64, nb * 32, scr, lane, a.in[I_NM]); continue; }
            r -= IT_BG;
            { const int which = r / IT_SQ; r -= which * IT_SQ; const int kb = r / 32, nb = r % 32;
              if (which == 0) p0_transpose_item(a.in[I_WCO], D, W4, 2048, 0, nb * 32, kb * 64, nb * 32, scr, lane);
              else if (which == 1) p0_transpose_item(a.in[I_WAO], D, W4, 2048, 1024, nb * 32, kb * 64, nb * 32, scr, lane);
              else p0_transpose_item(a.in[I_WOUT], D, W5, D, 0, nb * 32, kb * 64, nb * 32, scr, lane); }
        }
        const float* x = a.in[I_X]; const float* g1 = a.in[I_N1];
        f32x4 gv[4];
#pragma unroll
        for (int j = 0; j < 4; ++j) gv[j] = ((const f32x4*)g1)[64 * j + lane];
        for (int m0 = gw * 4; m0 < M; m0 += NGW * 4) {
            f32x4 v[4][4]; float sq[4];
#pragma unroll
            for (int r = 0; r < 4; ++r) { const f32x4* xr = (const f32x4*)(x + (size_t)(m0 + r) * D) + lane;
#pragma unroll
                for (int j = 0; j < 4; ++j) v[r][j] = xr[64 * j]; }
#pragma unroll
            for (int r = 0; r < 4; ++r) { float s = 0.f;
#pragma unroll
                for (int j = 0; j < 4; ++j) s += (v[r][j].x * v[r][j].x + v[r][j].y * v[r][j].y) + (v[r][j].z * v[r][j].z + v[r][j].w * v[r][j].w);
                sq[r] = s; }
#pragma unroll
            for (int o = 1; o < 64; o <<= 1) {
#pragma unroll
                for (int r = 0; r < 4; ++r) sq[r] += __shfl_xor(sq[r], o); }
#pragma unroll
            for (int r = 0; r < 4; ++r) { const float rstd = rsqrtf(sq[r] * (1.f / D) + EPS);
                u32x2* o8 = (u32x2*)(XN + (size_t)(m0 + r) * D) + lane;
#pragma unroll
                for (int j = 0; j < 4; ++j) { u32x2 o; o.x = cvtpk(v[r][j].x * rstd * gv[j].x, v[r][j].y * rstd * gv[j].y); o.y = cvtpk(v[r][j].z * rstd * gv[j].z, v[r][j].w * rstd * gv[j].w); o8[64 * j] = o; } }
        }
        asm volatile("s_waitcnt vmcnt(0) lgkmcnt(0)" ::: "memory"); __syncthreads();
    }
    SEAM(0);
    if (IN(1)) { pg8::Gemm g{XN, W1, D, 2 * FF, D}; pg8::StaticOrder S; S.init(M, 2 * FF, G, bx); pg8::EpiSwiglu E{HB, nullptr}; pg8::gemm_phase(lds, g, S, E); }
    SEAM(1);
    LAS float* red = (LAS float*)(lds + LDS_RED); LAS float* rstdl = (LAS float*)(lds + LDS_RSTD);
    if (IN(2)) { pg8::Gemm g{HB, W2, FF, D, FF}; pg8::StaticOrder S; S.init(M, D, G, bx); pg8::EpiResid<0> E{a.in[I_X], nullptr, nullptr, XN, 0.5f, PART1, red}; pg8::gemm_phase(lds, g, S, E); }
    SEAM(2);
    if (IN(3)) { pg8::Gemm g{XN, W3, D, NP, D}; pg8::StaticOrder S; S.init(M, NP, G, bx); rstd_prepass(S, PART1, rstdl, tid); pg8::EpiProj E{P, rstdl, a.in[I_BBG]}; pg8::gemm_phase(lds, g, S, E); }
    SEAM(3);
    if (IN(4)) {
        conv_pass(P, a.in[I_CONVW], vcu * 512 + tid, G * 512);
        {
            att::KVRegs R; int unit = vcu;
            if (unit < 1024) att::kv_load(R, P, unit, tid);
            for (; unit < 1024; unit += G) {
                att::kv_write(R, lds, a.in[I_KN], tid);
                __syncthreads();
                if (unit + G < 1024) att::kv_load(R, P, unit + G, tid);
                att::attn_compute(lds, P, a.in[I_QN], a.in[I_SINK], unit, wave, lane);
                __syncthreads();
            }
        }
        asm volatile("s_waitcnt vmcnt(0) lgkmcnt(0)" ::: "memory"); __syncthreads();
    }
    SEAM(4);
    bf16_t* MG = (bf16_t*)a.out;
    if (IN(5)) { pg8::Gemm g{P + PC_B, W4, NP, D, 2048}; pg8::StaticOrder S; S.init(M, D, G, bx); pg8::EpiMix E{P, MG}; pg8::gemm_phase(lds, g, S, E); }
    SEAM(5);
    if (IN(6)) { pg8::Gemm g{MG, W5, D, D, D}; pg8::StaticOrder S; S.init(M, D, G, bx); pg8::EpiResid<1> E{nullptr, XN, nullptr, X2G, 1.0f, PART2, red}; pg8::gemm_phase(lds, g, S, E); }
    SEAM(6);
    if (IN(7)) { pg8::Gemm g{X2G, W6, D, 2 * FF, D}; pg8::StaticOrder S; S.init(M, 2 * FF, G, bx); rstd_prepass(S, PART2, rstdl, tid); pg8::EpiSwiglu E{HB, rstdl}; pg8::gemm_phase(lds, g, S, E); }
    SEAM(7);
    if (IN(8)) { pg8::Gemm g{HB, W7, FF, D, FF}; pg8::StaticOrder S; S.init(M, D, G, bx); pg8::EpiResid<2> E{nullptr, X2G, a.out, nullptr, 0.5f, nullptr, red}; pg8::gemm_phase(lds, g, S, E); }
#undef IN
#undef SEAM
}

extern "C" void kernel_launch(void* const* d_in, const int* in_sizes, int n_in, void* d_out, int out_size, void* d_ws, size_t ws_size, hipStream_t stream) {
    static int grid = 0;
    if (grid == 0) {
        if (n_in != 20 || in_sizes[0] != M * D || out_size != M * D || ws_size < WS_END) { fprintf(stderr, "kernel_launch: unexpected shapes (n_in %d, in0 %d, out %d, ws %zu < %zu)\n", n_in, n_in > 0 ? in_sizes[0] : -1, out_size, ws_size, (size_t)WS_END); grid = -1; return; }
        int dev = 0, cus = 0, per_cu = 0;
        hipGetDevice(&dev); hipDeviceGetAttribute(&cus, hipDeviceAttributeMultiprocessorCount, dev);
        if (hipFuncSetAttribute((const void*)fwd, hipFuncAttributeMaxDynamicSharedMemorySize, LDS_BYTES) != hipSuccess) { fprintf(stderr, "kernel_launch: hipFuncSetAttribute failed\n"); grid = -1; return; }
        hipOccupancyMaxActiveBlocksPerMultiprocessor(&per_cu, (const void*)fwd, 512, LDS_BYTES);
        (void)hipGetLastError();
        if (per_cu < 1) per_cu = 1;
        grid = cus * 1;
        fprintf(stderr, "kernel_launch: cus %d per_cu %d grid %d\n", cus, per_cu, grid);
    }
    if (grid < 0) return;
    Args a{};
    for (int i = 0; i < 20; ++i) a.in[i] = (const float*)d_in[i];
    a.out = (float*)d_out; a.ws = (unsigned char*)d_ws;
#if MK_N_LAUNCHES == 1
    (void)hipMemsetAsync((char*)d_ws + WS_BAR, 0, XCD_BAR_WORDS * 4, stream);
    a.ph_lo = 0; a.ph_hi = 9;
    void* args[] = {&a};
    hipError_t e = hipLaunchCooperativeKernel((const void*)fwd, dim3(grid), dim3(512), args, LDS_BYTES, stream);
    if (e != hipSuccess) fprintf(stderr, "cooperative launch failed: %s (grid %d)\n", hipGetErrorString(e), grid);
#else
    for (int p = 0; p < 9; ++p) { a.ph_lo = p; a.ph_hi = p + 1; hipLaunchKernelGGL(fwd, dim3(grid), dim3(512), LDS_BYTES, stream, a); }
#endif
}
```

```cpp
#include <hip/hip_runtime.h>
#include <hip/hip_cooperative_groups.h>
#include <cstdio>
#include <cstdint>
namespace cg = cooperative_groups;

#ifndef MK_N_LAUNCHES
#define MK_N_LAUNCHES 1
#endif

#define LAS __attribute__((address_space(3)))
typedef unsigned short bf16_t;
typedef short bf16x8 __attribute__((ext_vector_type(8)));
typedef float f32x4 __attribute__((ext_vector_type(4)));
typedef float f32x16 __attribute__((ext_vector_type(16)));
typedef unsigned u32x4 __attribute__((ext_vector_type(4)));
typedef unsigned u32x2 __attribute__((ext_vector_type(2)));
typedef float f32x2_t __attribute__((ext_vector_type(2)));
typedef __bf16 bf16x2_t __attribute__((ext_vector_type(2)));

constexpr int M = 65536, D = 1024, FF = 2816, SEQ = 2048;
constexpr int NP = 5376;
constexpr int N3 = 6400;
constexpr int PC_Z = 0, PC_B = 1024, PC_Q = 2048, PC_K = 3072, PC_V = 3200, PC_GC = 3328, PC_GA = 4352;
constexpr float EPS = 1e-6f;
constexpr float LOG2E = 1.4426950408889634f;

constexpr size_t MiB = 1u << 20;
constexpr size_t WS_W1 = 0;
constexpr size_t WS_W2 = 11 * MiB;
constexpr size_t WS_W3 = 17 * MiB;
constexpr size_t WS_W4 = 30 * MiB;
constexpr size_t WS_W5 = 34 * MiB;
constexpr size_t WS_W6 = 36 * MiB;
constexpr size_t WS_W7 = 47 * MiB;
constexpr size_t WS_PART1 = 53 * MiB;
constexpr size_t WS_PART2 = 57 * MiB;
constexpr size_t WS_BAR = 61 * MiB;
constexpr size_t WS_XN = 64 * MiB;
constexpr size_t WS_P = 192 * MiB;
constexpr size_t WS_X2G = WS_P;
constexpr size_t WS_H = WS_P + 128 * MiB;
constexpr size_t WS_END = WS_P + 672 * MiB;

constexpr int RING_BYTES = 131072;
constexpr int LDS_BYTES = 163840;
constexpr int LDS_RED = RING_BYTES, LDS_BST = RING_BYTES + 4096, LDS_RSTD = RING_BYTES + 4160;

__device__ __forceinline__ unsigned cvtpk(float lo, float hi) { f32x2_t v = {lo, hi}; bf16x2_t b = __builtin_convertvector(v, bf16x2_t); return __builtin_bit_cast(unsigned, b); }
__device__ __forceinline__ float bflo(unsigned w) { return __uint_as_float(w << 16); }
__device__ __forceinline__ float bfhi(unsigned w) { return __uint_as_float(w & 0xffff0000u); }
__device__ __forceinline__ float sigmoidf_(float z) { return __builtin_amdgcn_rcpf(1.f + __expf(-z)); }
__device__ __forceinline__ float rstd_from_parts(const float* p) {
    const f32x4 a = *(const f32x4*)p;
    return rsqrtf(((a.x + a.y) + (a.z + a.w)) * (1.0f / 1024.0f) + EPS);
}

namespace pg8 {
constexpr int BM = 256, BK = 64, HALF = 128, HTB = HALF * BK * 2, STAGE_BYTES = 8 * HTB, NXCD = 8, WGM = 8;
__host__ __device__ __forceinline__ int lds_byte(int r, int c) { const int st = (r >> 4) * 2 + (c >> 5), rr = r & 15, cc = c & 31, ob = rr * 64 + cc * 2; return st * 1024 + (ob ^ (((ob >> 9) & 1) << 5)); }
__host__ __device__ __forceinline__ void stage_rc(int b, int& R, int& C) { const int st = b / 1024, sb = b % 1024, swz = sb ^ (((sb >> 9) & 1) << 5); R = (st >> 1) * 16 + swz / 64; C = (st & 1) * 32 + (swz % 64) / 2; }
__host__ __device__ __forceinline__ int perm32(int rho) { const int n = rho >> 4, i = rho & 15; return 8 * (i >> 2) + 4 * n + (i & 3); }

struct Unit { int pm, pn; };
struct Gemm { const bf16_t* A; const bf16_t* Bt; int lda, N, K; };

struct StaticOrder {
    int nM, nN, nwg, G, c;
    __device__ void init(int Mr, int N, int G_, int c_) { nM = Mr / BM; nN = N / BM; nwg = nM * nN; G = G_; c = c_; }
    __device__ bool next(int i, Unit& u) const {
        const long L = (long)i * G + c; if (L >= nwg) return false;
        int wgid = (int)L; { const int q = nwg / NXCD, r = nwg % NXCD, xcd = wgid % NXCD, off = wgid / NXCD; wgid = (xcd < r ? xcd * (q + 1) : r * (q + 1) + (xcd - r) * q) + off; }
        const int nig = WGM * nN, gid = wgid / nig, fm = gid * WGM, gsz = (nM - fm) < WGM ? (nM - fm) : WGM;
        u.pm = fm + ((wgid % nig) % gsz); u.pn = (wgid % nig) / gsz; return true;
    }
};

typedef f32x4 Acc[2][2][4][2];

struct EpiSwiglu {
    static constexpr bool HAS_MID = false; static constexpr int MID_T = -1;
    bf16_t* H; const LAS float* rtab;
    __device__ __forceinline__ void mid(Acc&, const Unit&, int, int, int, int) const {}
    __device__ __forceinline__ void operator()(const Acc& acc, const Unit& u, int wr, int wc, int fr, int fq, int ui) const {
        const int row0 = u.pm * BM + wr * 64 + fr, col0 = u.pn * HALF + wc * 32 + 8 * fq;
#pragma unroll
        for (int ai = 0; ai < 2; ++ai)
#pragma unroll
            for (int m = 0; m < 4; ++m) {
                const int row = row0 + ai * HALF + m * 16;
                const float rs = rtab ? rtab[ui * 256 + ai * HALF + wr * 64 + m * 16 + fr] : 1.0f;
                float h[8];
#pragma unroll
                for (int n = 0; n < 2; ++n)
#pragma unroll
                    for (int i = 0; i < 4; i += 2) {
                        const float g0 = acc[ai][0][m][n][i] * rs, g1 = acc[ai][0][m][n][i + 1] * rs, u0 = acc[ai][1][m][n][i] * rs, u1 = acc[ai][1][m][n][i + 1] * rs;
                        const float d0 = 1.f + __expf(fminf(-g0, 40.f)), d1 = 1.f + __expf(fminf(-g1, 40.f));
                        const float r = __builtin_amdgcn_rcpf(d0 * d1);
                        h[4 * n + i] = g0 * u0 * (d1 * r); h[4 * n + i + 1] = g1 * u1 * (d0 * r); }
                u32x4 w; w.x = cvtpk(h[0], h[1]); w.y = cvtpk(h[2], h[3]); w.z = cvtpk(h[4], h[5]); w.w = cvtpk(h[6], h[7]);
                *(u32x4*)(H + (size_t)row * FF + col0) = w;
            }
    }
};

template <int MODE> struct EpiResid {
    static constexpr bool HAS_MID = false; static constexpr int MID_T = -1;
    const float* basef; const bf16_t* baseb; float* outf; bf16_t* outb; float alpha; float* part; LAS float* red;
    __device__ __forceinline__ void mid(Acc&, const Unit&, int, int, int, int) const {}
    __device__ __forceinline__ void operator()(const Acc& acc, const Unit& u, int wr, int wc, int fr, int fq, int ui) const {
        const int row0 = u.pm * BM + wr * 64 + fr, col0 = u.pn * BM + wc * 32 + 8 * fq;
#pragma unroll
        for (int ai = 0; ai < 2; ++ai)
#pragma unroll
            for (int m = 0; m < 4; ++m) {
                const int row = row0 + ai * HALF + m * 16; float ss = 0.f;
#pragma unroll
                for (int bj = 0; bj < 2; ++bj) {
                    const size_t off = (size_t)row * D + col0 + bj * HALF;
                    f32x4 b0, b1;
                    if (MODE == 0) { b0 = *(const f32x4*)(basef + off); b1 = *(const f32x4*)(basef + off + 4); }
                    else { const u32x4 w = *(const u32x4*)(baseb + off); b0 = (f32x4){bflo(w.x), bfhi(w.x), bflo(w.y), bfhi(w.y)}; b1 = (f32x4){bflo(w.z), bfhi(w.z), bflo(w.w), bfhi(w.w)}; }
                    const f32x4 v0 = b0 + acc[ai][bj][m][0] * alpha, v1 = b1 + acc[ai][bj][m][1] * alpha;
                    if (MODE == 2) { *(f32x4*)(outf + off) = v0; *(f32x4*)(outf + off + 4) = v1; }
                    else {
                        ss += (v0.x * v0.x + v0.y * v0.y) + (v0.z * v0.z + v0.w * v0.w) + (v1.x * v1.x + v1.y * v1.y) + (v1.z * v1.z + v1.w * v1.w);
                        u32x4 w; w.x = cvtpk(v0.x, v0.y); w.y = cvtpk(v0.z, v0.w); w.z = cvtpk(v1.x, v1.y); w.w = cvtpk(v1.z, v1.w); *(u32x4*)(outb + off) = w;
                    }
                }
                if (MODE != 2) { ss += __shfl_xor(ss, 16); ss += __shfl_xor(ss, 32); if (fq == 0) red[(ai * HALF + wr * 64 + m * 16 + fr) * 4 + wc] = ss; }
            }
        if (MODE != 2) {
            asm volatile("s_waitcnt lgkmcnt(0)" ::: "memory"); __builtin_amdgcn_s_barrier(); asm volatile("" ::: "memory");
            const int t = threadIdx.x;
            if (t < 256) { const f32x4 r = *(const LAS f32x4*)(red + t * 4); part[(size_t)(u.pm * BM + t) * 4 + u.pn] = (r.x + r.y) + (r.z + r.w); }
            asm volatile("s_waitcnt lgkmcnt(0)" ::: "memory"); __builtin_amdgcn_s_barrier(); asm volatile("" ::: "memory");
        }
    }
};

struct EpiProj {
    static constexpr bool HAS_MID = false; static constexpr int MID_T = -1;
    bf16_t* P; const LAS float* rtab; const float* bias;
    __device__ __forceinline__ void mid(Acc&, const Unit&, int, int, int, int) const {}
    __device__ __forceinline__ void operator()(const Acc& acc, const Unit& u, int wr, int wc, int fr, int fq, int ui) const {
        const int row0 = u.pm * BM + wr * 64 + fr;
        if (u.pn < 8) {
            const int col0 = PC_Z + u.pn * HALF + wc * 32 + 8 * fq;
#pragma unroll
            for (int ai = 0; ai < 2; ++ai)
#pragma unroll
                for (int m = 0; m < 4; ++m) {
                    const int row = row0 + ai * HALF + m * 16; const float rs = rtab[ui * 256 + ai * HALF + wr * 64 + m * 16 + fr]; const float rs2 = rs * rs;
                    const f32x4 v0 = acc[ai][0][m][0] * acc[ai][1][m][0] * rs2, v1 = acc[ai][0][m][1] * acc[ai][1][m][1] * rs2;
                    u32x4 w; w.x = cvtpk(v0.x, v0.y); w.y = cvtpk(v0.z, v0.w); w.z = cvtpk(v1.x, v1.y); w.w = cvtpk(v1.z, v1.w);
                    *(u32x4*)(P + (size_t)row * NP + col0) = w;
                }
            return;
        }
        const int col0 = u.pn * BM - 1024 + wc * 32 + 8 * fq; const bool gate = u.pn >= 17;
        f32x4 bv[2][2];
#pragma unroll
        for (int bj = 0; bj < 2; ++bj)
#pragma unroll
            for (int n = 0; n < 2; ++n) bv[bj][n] = gate ? *(const f32x4*)(bias + (col0 - PC_GC) + bj * HALF + 4 * n) : (f32x4){0.f, 0.f, 0.f, 0.f};
#pragma unroll
        for (int ai = 0; ai < 2; ++ai)
#pragma unroll
            for (int m = 0; m < 4; ++m) {
                const int row = row0 + ai * HALF + m * 16; const float rs = rtab[ui * 256 + ai * HALF + wr * 64 + m * 16 + fr];
#pragma unroll
                for (int bj = 0; bj < 2; ++bj) {
                    f32x4 v0 = acc[ai][bj][m][0] * rs + bv[bj][0], v1 = acc[ai][bj][m][1] * rs + bv[bj][1];
                    if (gate) { v0.x = sigmoidf_(v0.x); v0.y = sigmoidf_(v0.y); v0.z = sigmoidf_(v0.z); v0.w = sigmoidf_(v0.w); v1.x = sigmoidf_(v1.x); v1.y = sigmoidf_(v1.y); v1.z = sigmoidf_(v1.z); v1.w = sigmoidf_(v1.w); }
                    u32x4 w; w.x = cvtpk(v0.x, v0.y); w.y = cvtpk(v0.z, v0.w); w.z = cvtpk(v1.x, v1.y); w.w = cvtpk(v1.z, v1.w);
                    *(u32x4*)(P + (size_t)row * NP + col0 + bj * HALF) = w;
                }
            }
    }
};

struct EpiMix {
    static constexpr bool HAS_MID = true; static constexpr int MID_T = 16;
    const bf16_t* P; bf16_t* out;
    __device__ __forceinline__ void mid(Acc& acc, const Unit& u, int wr, int wc, int fr, int fq) const {
        int row0 = u.pm * BM + wr * 64 + fr; const int col0 = u.pn * BM + wc * 32 + 8 * fq;
        asm volatile("" : "+v"(row0));
#pragma unroll
        for (int ai = 0; ai < 2; ++ai)
#pragma unroll
            for (int m = 0; m < 4; ++m) {
                const int row = row0 + ai * HALF + m * 16;
#pragma unroll
                for (int bj = 0; bj < 2; ++bj) {
                    const bf16_t* pr = P + (size_t)row * NP + col0 + bj * HALF;
                    const u32x4 gc = *(const u32x4*)(pr + PC_GC), ga = *(const u32x4*)(pr + PC_GA);
                    f32x4 r0, r1;
                    r0.x = bflo(gc.x) * __builtin_amdgcn_rcpf(fmaxf(bflo(ga.x), 1e-30f)); r0.y = bfhi(gc.x) * __builtin_amdgcn_rcpf(fmaxf(bfhi(ga.x), 1e-30f));
                    r0.z = bflo(gc.y) * __builtin_amdgcn_rcpf(fmaxf(bflo(ga.y), 1e-30f)); r0.w = bfhi(gc.y) * __builtin_amdgcn_rcpf(fmaxf(bfhi(ga.y), 1e-30f));
                    r1.x = bflo(gc.z) * __builtin_amdgcn_rcpf(fmaxf(bflo(ga.z), 1e-30f)); r1.y = bfhi(gc.z) * __builtin_amdgcn_rcpf(fmaxf(bfhi(ga.z), 1e-30f));
                    r1.z = bflo(gc.w) * __builtin_amdgcn_rcpf(fmaxf(bflo(ga.w), 1e-30f)); r1.w = bfhi(gc.w) * __builtin_amdgcn_rcpf(fmaxf(bfhi(ga.w), 1e-30f));
                    acc[ai][bj][m][0] *= r0; acc[ai][bj][m][1] *= r1;
                }
                if (m == 3) asm volatile("" ::: "memory");
            }
    }
    __device__ __forceinline__ void operator()(const Acc& acc, const Unit& u, int wr, int wc, int fr, int fq, int ui) const {
        const int row0 = u.pm * BM + wr * 64 + fr, col0 = u.pn * BM + wc * 32 + 8 * fq;
#pragma unroll
        for (int ai = 0; ai < 2; ++ai)
#pragma unroll
            for (int m = 0; m < 4; ++m) {
                const int row = row0 + ai * HALF + m * 16;
#pragma unroll
                for (int bj = 0; bj < 2; ++bj) {
                    const u32x4 ga = *(const u32x4*)(P + (size_t)row * NP + col0 + bj * HALF + PC_GA);
                    f32x4 g0, g1;
                    g0.x = fmaxf(bflo(ga.x), 1e-30f); g0.y = fmaxf(bfhi(ga.x), 1e-30f); g0.z = fmaxf(bflo(ga.y), 1e-30f); g0.w = fmaxf(bfhi(ga.y), 1e-30f);
                    g1.x = fmaxf(bflo(ga.z), 1e-30f); g1.y = fmaxf(bfhi(ga.z), 1e-30f); g1.z = fmaxf(bflo(ga.w), 1e-30f); g1.w = fmaxf(bfhi(ga.w), 1e-30f);
                    const f32x4 v0 = acc[ai][bj][m][0] * g0, v1 = acc[ai][bj][m][1] * g1;
                    u32x4 w; w.x = cvtpk(v0.x, v0.y); w.y = cvtpk(v0.z, v0.w); w.z = cvtpk(v1.x, v1.y); w.w = cvtpk(v1.z, v1.w);
                    *(u32x4*)(out + (size_t)row * D + col0 + bj * HALF) = w;
                }
            }
    }
};

template <class Epi>
__device__ __forceinline__ void gemm_phase(LAS unsigned char* lds, const Gemm g, const StaticOrder& S, const Epi& E) {
    const int tid = threadIdx.x, wid = __builtin_amdgcn_readfirstlane(tid >> 6), lane = tid & 63, wr = wid >> 2, wc = wid & 3, fr = lane & 15, fq = lane >> 4;
    const int K = g.K, nt = K / BK, lda = g.lda;
    unsigned voffA[2], voffB[2];
#pragma unroll
    for (int i = 0; i < 2; ++i) { int R, C; stage_rc(tid * 16 + i * 8192, R, C); const int Rb = (R & ~31) + perm32(R & 31);
        voffA[i] = (unsigned)(R * lda + C) * 2u; voffB[i] = (unsigned)(Rb * K + C) * 2u; }
    const size_t kstep = (size_t)(BK * 2);
    const size_t hstepA = (size_t)HALF * lda * 2, hstepB = (size_t)HALF * K * 2;
    const size_t tstepA = 2 * hstepA, tstepB = 2 * hstepB;
    const unsigned ldsw = (unsigned)wid * 1024u;
    const int aoff = lds_byte(wr * 64 + fr, fq * 8), boff = lds_byte(wc * 32 + fr, fq * 8);
#define PG8_SA(b, h) (((b) * 2 + (h)) * HTB)
#define PG8_SB(b, h) ((4 + (b) * 2 + (h)) * HTB)
#define PG8_STAGE(bufoff, gbase, voff) do { _Pragma("unroll") for (int _i = 0; _i < 2; ++_i) \
        __builtin_amdgcn_global_load_lds((const unsigned*)((const char*)(gbase) + (voff)[_i]), (LAS unsigned*)(lds + (bufoff) + ldsw + _i * 8192), 16, 0, 0); } while (0)
#define PG8_LDA(dst, b, h) do { _Pragma("unroll") for (int m = 0; m < 4; ++m) _Pragma("unroll") for (int k = 0; k < 2; ++k) dst[m][k] = *(const LAS bf16x8*)(lds + PG8_SA(b, h) + aoff + m * 2048 + k * 1024); } while (0)
#define PG8_LDB(dst, b, h) do { _Pragma("unroll") for (int n = 0; n < 2; ++n) _Pragma("unroll") for (int k = 0; k < 2; ++k) dst[n][k] = *(const LAS bf16x8*)(lds + PG8_SB(b, h) + boff + n * 2048 + k * 1024); } while (0)
#define PG8_MMA(ai, bj, At, Bt) do { __builtin_amdgcn_s_setprio(1); _Pragma("unroll") for (int m = 0; m < 4; ++m) _Pragma("unroll") for (int n = 0; n < 2; ++n) _Pragma("unroll") for (int k = 0; k < 2; ++k) \
        acc[ai][bj][m][n] = __builtin_amdgcn_mfma_f32_16x16x32_bf16(Bt[n][k], At[m][k], acc[ai][bj][m][n], 0, 0, 0); __builtin_amdgcn_s_setprio(0); } while (0)
#define PG8_WAIT_V(n) asm volatile("s_waitcnt vmcnt(" #n ")" ::: "memory")
#define PG8_WAIT_L(n) asm volatile("s_waitcnt lgkmcnt(" #n ")" ::: "memory")
#define PG8_BAR __builtin_amdgcn_s_barrier()
#define PG8_SCHED __builtin_amdgcn_sched_barrier(0)
    Unit cur, nxt; int ui = 0;
    if (!S.next(0, cur)) return;
    Acc acc;
#pragma unroll
    for (int a = 0; a < 2; ++a)
#pragma unroll
        for (int b = 0; b < 2; ++b)
#pragma unroll
            for (int m = 0; m < 4; ++m)
#pragma unroll
                for (int n = 0; n < 2; ++n) acc[a][b][m][n] = (f32x4){0.f, 0.f, 0.f, 0.f};
    bf16x8 At[4][2], B0[2][2], B1[2][2];
    const char* cA = (const char*)g.A + (size_t)cur.pm * tstepA; const char* cB = (const char*)g.Bt + (size_t)cur.pn * tstepB;
    PG8_STAGE(PG8_SB(0, 0), cB, voffB); PG8_STAGE(PG8_SB(0, 1), cB + hstepB, voffB); PG8_STAGE(PG8_SA(0, 0), cA, voffA); PG8_STAGE(PG8_SA(0, 1), cA + hstepA, voffA);
    if (wr == 1) PG8_BAR;
    PG8_WAIT_V(2); PG8_BAR;
    PG8_STAGE(PG8_SB(1, 0), cB + kstep, voffB); PG8_STAGE(PG8_SA(1, 0), cA + kstep, voffA); PG8_STAGE(PG8_SB(1, 1), cB + hstepB + kstep, voffB);
    PG8_WAIT_V(6); PG8_BAR;
    for (;;) {
        const bool has_next = S.next(ui + 1, nxt);
        const char* nA = has_next ? (const char*)g.A + (size_t)nxt.pm * tstepA : cA; const char* nB = has_next ? (const char*)g.Bt + (size_t)nxt.pn * tstepB : cB;
        for (int t = 0; t < nt; t += 2) {
            if constexpr (Epi::HAS_MID) { if (t == Epi::MID_T) { E.mid(acc, cur, wr, wc, fr, fq); PG8_SCHED; } }
            const bool last = (t == nt - 2);
            const char* a1 = cA + (size_t)(t + 1) * kstep;
            const char* a2 = last ? nA : cA + (size_t)(t + 2) * kstep; const char* b2 = last ? nB : cB + (size_t)(t + 2) * kstep;
            const char* a3 = a2 + kstep; const char* b3 = b2 + kstep;
            PG8_LDB(B0, 0, 0); PG8_LDB(B1, 0, 1); PG8_SCHED; PG8_LDA(At, 0, 0); PG8_STAGE(PG8_SA(1, 1), a1 + hstepA, voffA);
            PG8_WAIT_V(8); PG8_WAIT_L(0); PG8_BAR; PG8_MMA(0, 0, At, B0); PG8_MMA(0, 1, At, B1); PG8_BAR; PG8_SCHED;
            PG8_LDA(At, 0, 1); PG8_STAGE(PG8_SB(0, 0), b2, voffB); PG8_STAGE(PG8_SB(0, 1), b2 + hstepB, voffB); PG8_STAGE(PG8_SA(0, 0), a2, voffA);
            PG8_WAIT_V(8); PG8_WAIT_L(0); PG8_BAR; PG8_MMA(1, 0, At, B0); PG8_MMA(1, 1, At, B1); PG8_BAR; PG8_SCHED;
            PG8_LDB(B0, 1, 0); PG8_LDB(B1, 1, 1); PG8_SCHED; PG8_LDA(At, 1, 0); PG8_STAGE(PG8_SA(0, 1), a2 + hstepA, voffA);
            PG8_WAIT_V(8); PG8_WAIT_L(0); PG8_BAR; PG8_MMA(0, 0, At, B0); PG8_MMA(0, 1, At, B1); PG8_BAR; PG8_SCHED;
            PG8_LDA(At, 1, 1); PG8_STAGE(PG8_SB(1, 0), b3, voffB); PG8_STAGE(PG8_SB(1, 1), b3 + hstepB, voffB); PG8_STAGE(PG8_SA(1, 0), a3, voffA);
            PG8_WAIT_V(8); PG8_WAIT_L(0); PG8_BAR; PG8_MMA(1, 0, At, B0); PG8_MMA(1, 1, At, B1); PG8_BAR; PG8_SCHED;
        }
        if (wr == 0) PG8_BAR;
        E(acc, cur, wr, wc, fr, fq, ui);
        if (!has_next) break;
#pragma unroll
        for (int a = 0; a < 2; ++a)
#pragma unroll
            for (int b = 0; b < 2; ++b)
#pragma unroll
                for (int m = 0; m < 4; ++m)
#pragma unroll
                    for (int n = 0; n < 2; ++n) acc[a][b][m][n] = (f32x4){0.f, 0.f, 0.f, 0.f};
        cur = nxt; cA = nA; cB = nB; ++ui;
        if (wr == 1) PG8_BAR;
    }
    PG8_WAIT_V(0);
    PG8_BAR;
#undef PG8_SA
#undef PG8_SB
#undef PG8_STAGE
#undef PG8_LDA
#undef PG8_LDB
#undef PG8_MMA
#undef PG8_WAIT_V
#undef PG8_WAIT_L
#undef PG8_BAR
#undef PG8_SCHED
}
}

__device__ __forceinline__ float wave_sum(float v) {
#pragma unroll
    for (int o = 1; o < 64; o <<= 1) v += __shfl_xor(v, o);
    return v;
}
__device__ __forceinline__ void p0_transpose_item(const float* W, int N, bf16_t* WT, int ldk, int koff, int drow0, int k0, int n0, LAS float* scr, int lane, const float* ksc = nullptr) {
#pragma unroll 8
    for (int i = 0; i < 32; ++i) { const int kk = 2 * i + (lane >> 5); const float sc = ksc ? ksc[k0 + kk] : 1.0f; scr[kk * 33 + (lane & 31)] = W[(size_t)(k0 + kk) * N + n0 + (lane & 31)] * sc; }
    asm volatile("s_waitcnt lgkmcnt(0)" ::: "memory");
    const int c = lane & 7;
#pragma unroll
    for (int j = 0; j < 4; ++j) { const int n = (lane >> 3) + 8 * j; const LAS float* s = scr + (8 * c) * 33 + n;
        u32x4 o; o.x = cvtpk(s[0 * 33], s[1 * 33]); o.y = cvtpk(s[2 * 33], s[3 * 33]); o.z = cvtpk(s[4 * 33], s[5 * 33]); o.w = cvtpk(s[6 * 33], s[7 * 33]);
        *(u32x4*)(WT + (size_t)(drow0 + n) * ldk + koff + k0 + 8 * c) = o; }
    asm volatile("s_waitcnt lgkmcnt(0)" ::: "memory");
}

namespace att {
constexpr int KPB = 144;
constexpr int VP = 260;
constexpr int LDS_K = 0, LDS_V = 36864, LDS_WS = 70144, LDS_OST = 72192, LDS_END = 104960;
__device__ __forceinline__ int crow(int r, int hi) { return (r & 3) + 8 * (r >> 2) + 4 * hi; }

struct KVRegs { u32x4 kr[4], vr[4]; };
__device__ __forceinline__ void kv_load(KVRegs& R, const bf16_t* P, int unit, int tid) {
    const int hk = unit & 1, n = (unit >> 1) & 15, b = unit >> 5;
    const int kk = tid >> 1, half = tid & 1; const int kp = n * 128 - 128 + kk;
    if (kp >= 0) { const bf16_t* pr = P + ((size_t)b * SEQ + kp) * NP + PC_K + hk * 64 + half * 32;
#pragma unroll
        for (int i = 0; i < 4; ++i) { R.kr[i] = *(const u32x4*)(pr + 8 * i); R.vr[i] = *(const u32x4*)(pr + 128 + 8 * i); } }
    else {
#pragma unroll
        for (int i = 0; i < 4; ++i) { R.kr[i] = (u32x4){0u, 0u, 0u, 0u}; R.vr[i] = (u32x4){0u, 0u, 0u, 0u}; } }
}
__device__ __forceinline__ void kv_write(const KVRegs& R, LAS unsigned char* lds, const float* kn_w, int tid) {
    const int kk = tid >> 1, half = tid & 1;
    float ss = 0.f;
#pragma unroll
    for (int i = 0; i < 4; ++i)
#pragma unroll
        for (int e = 0; e < 4; ++e) { const float a = bflo(R.kr[i][e]), c = bfhi(R.kr[i][e]); ss += a * a + c * c; }
    ss += __shfl_xor(ss, 1);
    const float rs = rsqrtf(ss * (1.0f / 64.0f) + EPS);
#pragma unroll
    for (int i = 0; i < 4; ++i) {
        const f32x4 w0 = *(const f32x4*)(kn_w + half * 32 + 8 * i), w1 = *(const f32x4*)(kn_w + half * 32 + 8 * i + 4);
        u32x4 o;
        o.x = cvtpk(bflo(R.kr[i].x) * rs * w0.x, bfhi(R.kr[i].x) * rs * w0.y); o.y = cvtpk(bflo(R.kr[i].y) * rs * w0.z, bfhi(R.kr[i].y) * rs * w0.w);
        o.z = cvtpk(bflo(R.kr[i].z) * rs * w1.x, bfhi(R.kr[i].z) * rs * w1.y); o.w = cvtpk(bflo(R.kr[i].w) * rs * w1.z, bfhi(R.kr[i].w) * rs * w1.w);
        *(LAS u32x4*)(lds + LDS_K + kk * KPB + half * 64 + 16 * i) = o;
    }
#pragma unroll
    for (int i = 0; i < 4; ++i)
#pragma unroll
        for (int e = 0; e < 8; ++e) {
            const unsigned short val = (unsigned short)((R.vr[i][e >> 1] >> (16 * (e & 1))) & 0xffffu);
            *(LAS unsigned short*)(lds + LDS_V + ((half * 32 + 8 * i + e) * VP + kk) * 2) = val;
        }
}
__device__ __forceinline__ void attn_compute(LAS unsigned char* lds, bf16_t* P, const float* qn_w, const float* sinks, int unit, int wid, int lane) {
    const int hk = unit & 1, n = (unit >> 1) & 15, b = unit >> 5;
    const int T0 = n * 128; const size_t rowbase = (size_t)b * SEQ;
    const int h = hk * 8 + wid, r32 = lane & 31, hi = lane >> 5;
    const float sink2 = sinks[h] * LOG2E;
    LAS float* wsf = (LAS float*)(lds + LDS_WS) + wid * 64;
    LAS bf16_t* stg = (LAS bf16_t*)(lds + LDS_OST) + wid * 2048;
    const float NEG = -1e30f;
    u32x4 qnext[4];
    { const bf16_t* qp = P + (rowbase + T0 + r32) * NP + PC_Q + h * 64;
#pragma unroll
      for (int d0 = 0; d0 < 4; ++d0) qnext[d0] = *(const u32x4*)(qp + 16 * d0 + 8 * hi); }
#pragma unroll 1
    for (int j = 0; j < 4; ++j) {
        u32x4 qraw[4]; float ss = 0.f;
#pragma unroll
        for (int d0 = 0; d0 < 4; ++d0) { qraw[d0] = qnext[d0];
#pragma unroll
            for (int e = 0; e < 4; ++e) { const float a = bflo(qraw[d0][e]), c = bfhi(qraw[d0][e]); ss += a * a + c * c; } }
        if (j < 3) { const bf16_t* qp = P + (rowbase + T0 + 32 * (j + 1) + r32) * NP + PC_Q + h * 64;
#pragma unroll
            for (int d0 = 0; d0 < 4; ++d0) qnext[d0] = *(const u32x4*)(qp + 16 * d0 + 8 * hi); }
        ss += __shfl_xor(ss, 32);
        const float rs = rsqrtf(ss * (1.0f / 64.0f) + EPS) * (0.125f * LOG2E);
        bf16x8 qr[4];
#pragma unroll
        for (int d0 = 0; d0 < 4; ++d0) {
            const f32x4 w0 = *(const f32x4*)(qn_w + 16 * d0 + 8 * hi), w1 = *(const f32x4*)(qn_w + 16 * d0 + 8 * hi + 4);
            u32x4 o;
            o.x = cvtpk(bflo(qraw[d0].x) * rs * w0.x, bfhi(qraw[d0].x) * rs * w0.y); o.y = cvtpk(bflo(qraw[d0].y) * rs * w0.z, bfhi(qraw[d0].y) * rs * w0.w);
            o.z = cvtpk(bflo(qraw[d0].z) * rs * w1.x, bfhi(qraw[d0].z) * rs * w1.y); o.w = cvtpk(bflo(qraw[d0].w) * rs * w1.z, bfhi(qraw[d0].w) * rs * w1.w);
            qr[d0] = __builtin_bit_cast(bf16x8, o);
        }
        f32x16 S[5];
#pragma unroll
        for (int c = 0; c < 5; ++c) {
            f32x16 p;
#pragma unroll
            for (int r = 0; r < 16; ++r) p[r] = 0.f;
#pragma unroll
            for (int d0 = 0; d0 < 4; ++d0) {
                const bf16x8 kf = *(const LAS bf16x8*)(lds + LDS_K + (32 * (j + c) + r32) * KPB + (16 * d0 + 8 * hi) * 2);
                p = __builtin_amdgcn_mfma_f32_32x32x16_bf16(kf, qr[d0], p, 0, 0, 0);
            }
            S[c] = p;
        }
#pragma unroll
        for (int r = 0; r < 16; ++r) { const int kl = crow(r, hi); if (!(kl > r32)) S[0][r] = NEG; if (!(kl <= r32)) S[4][r] = NEG; }
        if (n == 0) {
#pragma unroll
            for (int c = 0; c < 5; ++c) if (j + c < 4) {
#pragma unroll
                for (int r = 0; r < 16; ++r) S[c][r] = NEG; }
        }
        float mx = sink2;
#pragma unroll
        for (int c = 0; c < 5; ++c)
#pragma unroll
            for (int r = 0; r < 16; ++r) mx = fmaxf(mx, S[c][r]);
        mx = fmaxf(mx, __shfl_xor(mx, 32));
        float l = 0.f;
#pragma unroll
        for (int c = 0; c < 5; ++c)
#pragma unroll
            for (int r = 0; r < 16; ++r) { const float p = __builtin_amdgcn_exp2f(S[c][r] - mx); S[c][r] = p; l += p; }
        l += __shfl_xor(l, 32);
        l += __builtin_amdgcn_exp2f(sink2 - mx);
        f32x16 o0, o1;
#pragma unroll
        for (int r = 0; r < 16; ++r) { o0[r] = 0.f; o1[r] = 0.f; }
#pragma unroll
        for (int c = 0; c < 5; ++c)
#pragma unroll
            for (int s = 0; s < 2; ++s) {
                u32x4 pw; pw.x = cvtpk(S[c][8 * s + 0], S[c][8 * s + 1]); pw.y = cvtpk(S[c][8 * s + 2], S[c][8 * s + 3]); pw.z = cvtpk(S[c][8 * s + 4], S[c][8 * s + 5]); pw.w = cvtpk(S[c][8 * s + 6], S[c][8 * s + 7]);
                const bf16x8 pa = __builtin_bit_cast(bf16x8, pw);
                const int kv0 = 32 * (j + c) + 16 * s + 4 * hi;
                { const LAS unsigned char* va = lds + LDS_V + (r32 * VP + kv0) * 2;
                  const u32x2 lo = *(const LAS u32x2*)va, hh = *(const LAS u32x2*)(va + 16);
                  const u32x4 vb = {lo.x, lo.y, hh.x, hh.y};
                  o0 = __builtin_amdgcn_mfma_f32_32x32x16_bf16(pa, __builtin_bit_cast(bf16x8, vb), o0, 0, 0, 0); }
                { const LAS unsigned char* va = lds + LDS_V + ((32 + r32) * VP + kv0) * 2;
                  const u32x2 lo = *(const LAS u32x2*)va, hh = *(const LAS u32x2*)(va + 16);
                  const u32x4 vb = {lo.x, lo.y, hh.x, hh.y};
                  o1 = __builtin_amdgcn_mfma_f32_32x32x16_bf16(pa, __builtin_bit_cast(bf16x8, vb), o1, 0, 0, 0); }
            }
        if (hi == 0) wsf[r32] = __builtin_amdgcn_rcpf(l);
        asm volatile("s_waitcnt lgkmcnt(0)" ::: "memory");
#pragma unroll
        for (int r = 0; r < 16; ++r) { const int orow = crow(r, hi); const float rl = wsf[orow];
            stg[orow * 64 + r32] = (bf16_t)(cvtpk(o0[r] * rl, 0.f) & 0xffffu); stg[orow * 64 + 32 + r32] = (bf16_t)(cvtpk(o1[r] * rl, 0.f) & 0xffffu); }
        asm volatile("s_waitcnt lgkmcnt(0)" ::: "memory");
#pragma unroll
        for (int i = 0; i < 4; ++i) { const int row = i * 8 + (lane >> 3), ch = lane & 7; const u32x4 v = *(const LAS u32x4*)(stg + row * 64 + ch * 8);
            *(u32x4*)(P + (rowbase + T0 + 32 * j + row) * NP + PC_Q + h * 64 + ch * 8) = v; }
        asm volatile("s_waitcnt lgkmcnt(0)" ::: "memory");
    }
}
}

__device__ __forceinline__ void conv_pass(bf16_t* P, const float* cw, int gtid, int nthreads) {
    for (int it = gtid; it < (M / 16) * 128; it += nthreads) {
        const int c8 = (it & 127) * 8; const size_t r0 = (size_t)(it >> 7) * 16; const int t0 = (int)(r0 & (SEQ - 1));
        float w0[8], w1[8], w2[8], z1[8], z2[8];
        { const f32x4 a = *(const f32x4*)(cw + c8), b = *(const f32x4*)(cw + c8 + 4); w0[0] = a.x; w0[1] = a.y; w0[2] = a.z; w0[3] = a.w; w0[4] = b.x; w0[5] = b.y; w0[6] = b.z; w0[7] = b.w; }
        { const f32x4 a = *(const f32x4*)(cw + D + c8), b = *(const f32x4*)(cw + D + c8 + 4); w1[0] = a.x; w1[1] = a.y; w1[2] = a.z; w1[3] = a.w; w1[4] = b.x; w1[5] = b.y; w1[6] = b.z; w1[7] = b.w; }
        { const f32x4 a = *(const f32x4*)(cw + 2 * D + c8), b = *(const f32x4*)(cw + 2 * D + c8 + 4); w2[0] = a.x; w2[1] = a.y; w2[2] = a.z; w2[3] = a.w; w2[4] = b.x; w2[5] = b.y; w2[6] = b.z; w2[7] = b.w; }
        if (t0 == 0) {
#pragma unroll
            for (int e = 0; e < 8; ++e) { z1[e] = 0.f; z2[e] = 0.f; }
        } else {
            const u32x4 za = *(const u32x4*)(P + (r0 - 2) * NP + PC_Z + c8), zb = *(const u32x4*)(P + (r0 - 1) * NP + PC_Z + c8);
#pragma unroll
            for (int e = 0; e < 4; ++e) { z2[2 * e] = bflo(za[e]); z2[2 * e + 1] = bfhi(za[e]); z1[2 * e] = bflo(zb[e]); z1[2 * e + 1] = bfhi(zb[e]); }
        }
#pragma unroll 8
        for (int rr = 0; rr < 16; ++rr) {
            bf16_t* pr = P + (r0 + rr) * NP + c8;
            const u32x4 zz = *(const u32x4*)(pr + PC_Z), bb = *(const u32x4*)(pr + PC_B);
            float z0[8], y[8];
#pragma unroll
            for (int e = 0; e < 4; ++e) { z0[2 * e] = bflo(zz[e]); z0[2 * e + 1] = bfhi(zz[e]); }
#pragma unroll
            for (int e = 0; e < 8; ++e) y[e] = w0[e] * z2[e] + w1[e] * z1[e] + w2[e] * z0[e];
            u32x4 o;
#pragma unroll
            for (int e = 0; e < 4; ++e) o[e] = cvtpk(bflo(bb[e]) * y[2 * e], bfhi(bb[e]) * y[2 * e + 1]);
            *(u32x4*)(pr + PC_B) = o;
#pragma unroll
            for (int e = 0; e < 8; ++e) { z2[e] = z1[e]; z1[e] = z0[e]; }
        }
    }
}

#define XB_TMO      128
#define XB_XCNT(j)  (256  + 64 * (j))
#define XB_XSUB(j)  (1280 + 64 * (j))
#define XB_XGEN(j)  (2304 + 64 * (j))
#define XB_TOP      3328
#define XB_TOPGEN   3392
#define XCD_BAR_WORDS 3456
#define XB_SPIN_CAP (1u << 22)
__device__ __forceinline__ unsigned xb_ld(unsigned* p)              { return __hip_atomic_load(p, __ATOMIC_RELAXED, __HIP_MEMORY_SCOPE_AGENT); }
__device__ __forceinline__ unsigned xb_add(unsigned* p, unsigned v) { return __hip_atomic_fetch_add(p, v, __ATOMIC_RELAXED, __HIP_MEMORY_SCOPE_AGENT); }
__device__ __forceinline__ unsigned xb_xcc_id() { return (unsigned)__builtin_amdgcn_s_getreg((3 << 11) | 20) & 0xFu; }
#define XB_SPIN(cond, bar) do { unsigned _sp = 0; while (cond) { __builtin_amdgcn_s_sleep(1); \
    if ((++_sp & 255u) == 0u) { if (xb_ld(&(bar)[XB_TMO])) break; if (_sp > XB_SPIN_CAP) { atomicAdd(&(bar)[XB_TMO], 1u); break; } } } } while (0)
struct XcdBarrier { unsigned* bar; unsigned x; volatile LAS unsigned* st; };
__device__ __forceinline__ XcdBarrier xcd_barrier_post(unsigned* bar, volatile LAS unsigned* st) {
    XcdBarrier b; b.bar = bar; b.x = xb_xcc_id(); b.st = st;
    if (threadIdx.x == 0) (void)xb_add(&bar[XB_XCNT(b.x)], 1u);
    return b;
}
__device__ __forceinline__ void xcd_barrier_complete(unsigned* bar, unsigned x, unsigned& nloc, unsigned& nx) {
    const unsigned G = gridDim.x * gridDim.y * gridDim.z;
    unsigned sum, cnt, mine, sp = 0u;
    for (;;) {
        sum = 0u; cnt = 0u; mine = 0u;
#pragma unroll
        for (unsigned j = 0; j < 16; ++j) { const unsigned c = xb_ld(&bar[XB_XCNT(j)]); sum += c; cnt += (c > 0u) ? 1u : 0u; mine = (j == x) ? c : mine; }
        if (sum == G) break;
        __builtin_amdgcn_s_sleep(1);
        if ((++sp & 255u) == 0u) { if (xb_ld(&bar[XB_TMO])) break; if (sp > XB_SPIN_CAP) { atomicAdd(&bar[XB_TMO], 1u); break; } }
    }
    nloc = mine > 0u ? mine : 1u; nx = cnt > 0u ? cnt : 1u;
}
__device__ __forceinline__ void xcd_barrier(const XcdBarrier& b) {
    asm volatile("s_waitcnt vmcnt(0)" ::: "memory");
    __syncthreads();
    if (threadIdx.x == 0) {
        unsigned* bar = b.bar;
        __builtin_amdgcn_s_waitcnt(0);
        unsigned nloc = b.st[0], nx = b.st[1];
        if (nloc == 0u) { xcd_barrier_complete(bar, b.x, nloc, nx); b.st[0] = nloc; b.st[1] = nx; }
        const unsigned old = xb_add(&bar[XB_XSUB(b.x)], 1u);
        const unsigned gen = old / nloc;
        if (old + 1u == (gen + 1u) * nloc) {
            __builtin_amdgcn_fence(__ATOMIC_RELEASE, "agent");
            asm volatile("s_waitcnt vmcnt(0)" ::: "memory");
            const unsigned og = xb_add(&bar[XB_TOP], 1u);
            const unsigned tg = og / nx;
            if (og + 1u == (tg + 1u) * nx) xb_add(&bar[XB_TOPGEN], 1u);
            else XB_SPIN(xb_ld(&bar[XB_TOPGEN]) == tg, bar);
            __builtin_amdgcn_fence(__ATOMIC_ACQUIRE, "agent");
            xb_add(&bar[XB_XGEN(b.x)], 1u);
            asm volatile("s_waitcnt vmcnt(0)" ::: "memory");
        } else {
            XB_SPIN(xb_ld(&bar[XB_XGEN(b.x)]) == gen, bar);
            __builtin_amdgcn_fence(__ATOMIC_ACQUIRE, "agent");
            asm volatile("s_waitcnt vmcnt(0)" ::: "memory");
        }
    }
    __syncthreads();
}

__device__ __forceinline__ void rstd_prepass(const pg8::StaticOrder& S, const float* part, LAS float* tab, int tid) {
    if (tid < 256) {
        for (int i0 = 0; i0 < 32; i0 += 8) {
            f32x4 v[8]; bool ok[8];
#pragma unroll
            for (int j = 0; j < 8; ++j) { pg8::Unit u; ok[j] = S.next(i0 + j, u); v[j] = ok[j] ? *(const f32x4*)(part + (size_t)(u.pm * 256 + tid) * 4) : (f32x4){0.f, 0.f, 0.f, 0.f}; }
#pragma unroll
            for (int j = 0; j < 8; ++j) if (ok[j] && (i0 + j) < 25) tab[(i0 + j) * 256 + tid] = rsqrtf(((v[j].x + v[j].y) + (v[j].z + v[j].w)) * (1.0f / 1024.0f) + EPS);
        }
    }
    asm volatile("s_waitcnt vmcnt(0) lgkmcnt(0)" ::: "memory"); __syncthreads();
}

struct Args { const float* in[20]; float* out; unsigned char* ws; int ph_lo, ph_hi; };
enum { I_X = 0, I_N1, I_WG1, I_WU1, I_WD1, I_NM, I_WIN, I_CONVW, I_QN, I_KN, I_SINK, I_WCO, I_WAO, I_WBG, I_BBG, I_WOUT, I_N2, I_WG2, I_WU2, I_WD2 };

__global__ void __launch_bounds__(512, 2) fwd(Args a) {
    extern __shared__ __attribute__((aligned(16))) unsigned char lds_raw[];
    LAS unsigned char* lds = (LAS unsigned char*)lds_raw;
    const int tid = threadIdx.x, lane = tid & 63, wave = __builtin_amdgcn_readfirstlane(tid >> 6);
    const int G = gridDim.x, bx = blockIdx.x;
    const int vcu = (G % 8 == 0) ? (bx % 8) * (G / 8) + bx / 8 : bx;
    unsigned char* ws = a.ws;
    bf16_t* W1 = (bf16_t*)(ws + WS_W1); bf16_t* W2 = (bf16_t*)(ws + WS_W2); bf16_t* W3 = (bf16_t*)(ws + WS_W3); bf16_t* W4 = (bf16_t*)(ws + WS_W4);
    bf16_t* W5 = (bf16_t*)(ws + WS_W5); bf16_t* W6 = (bf16_t*)(ws + WS_W6); bf16_t* W7 = (bf16_t*)(ws + WS_W7);
    float* PART1 = (float*)(ws + WS_PART1); float* PART2 = (float*)(ws + WS_PART2);
    bf16_t* XN = (bf16_t*)(ws + WS_XN); bf16_t* P = (bf16_t*)(ws + WS_P); bf16_t* X2G = (bf16_t*)(ws + WS_X2G); bf16_t* HB = (bf16_t*)(ws + WS_H);
    const int lo = a.ph_lo, hi = a.ph_hi;
#ifndef PH_MASK
#define PH_MASK 0x1ff
#endif
#define IN(k) (((PH_MASK >> (k)) & 1) && lo <= (k) && (k) < hi)
    volatile LAS unsigned* bst = (volatile LAS unsigned*)(lds + LDS_BST);
    if (tid < 2) bst[tid] = 0u;
    __syncthreads();
#if MK_N_LAUNCHES == 1
    XcdBarrier xbar = xcd_barrier_post((unsigned*)(ws + WS_BAR), bst);
    if (a.ph_lo < 0) cg::this_grid().sync();
#define SEAM(k) do { if (IN(k) && IN((k) + 1)) xcd_barrier(xbar); } while (0)
#else
#define SEAM(k) do { } while (0)
#endif

    if (IN(0)) {
        LAS float* scr = (LAS float*)(lds + wave * 16384);
        const int gw = vcu * 8 + wave, NGW = G * 8;
        constexpr int NB_FF = FF / 32, IT_GU = 16 * NB_FF, IT_DN = (FF / 64) * 32, IT_IN = 16 * 136, IT_BG = 16 * 64, IT_SQ = 16 * 32;
        constexpr int NITEMS = 4 * IT_GU + 2 * IT_DN + IT_IN + IT_BG + 3 * IT_SQ;
        for (int it = gw; it < NITEMS; it += NGW) {
            int r = it;
            if (r < 4 * IT_GU) {
                const int which = r / IT_GU; r -= which * IT_GU; const int kb = r / NB_FF, nb = r % NB_FF, n0 = nb * 32;
                const float* W = a.in[which == 0 ? I_WG1 : which == 1 ? I_WU1 : which == 2 ? I_WG2 : I_WU2];
                p0_transpose_item(W, FF, (which < 2) ? W1 : W6, D, 0, 256 * (n0 >> 7) + 128 * (which & 1) + (n0 & 127), kb * 64, n0, scr, lane, (which < 2) ? nullptr : a.in[I_N2]); continue; }
            r -= 4 * IT_GU;
            if (r < 2 * IT_DN) { const int which = r / IT_DN; r -= which * IT_DN; const int kb = r / 32, nb = r % 32;
                p0_transpose_item(a.in[which ? I_WD2 : I_WD1], D, which ? W7 : W2, FF, 0, nb * 32, kb * 64, nb * 32, scr, lane); continue; }
            r -= 2 * IT_DN;
            if (r < IT_IN) { const int kb = r / 136, nb = r % 136, n0 = nb * 32;
                const int cz = (n0 - 1024) & 1023;
                const int dr = n0 < 1024 ? n0 + 2048 : (n0 < 2048 ? 256 * (cz >> 7) + (cz & 127) : (n0 < 3072 ? 256 * (cz >> 7) + 128 + (cz & 127) : n0));
                p0_transpose_item(a.in[I_WIN], 4352, W3, D, 0, dr, kb * 64, n0, scr, lane, a.in[I_NM]); continue; }
            r -= IT_IN;
            if (r < IT_BG) { const int kb = r / 64, nb = r % 64; p0_transpose_item(a.in[I_WBG], 2048, W3, D, 0, 4352 + nb * 32, kb * 64, nb * 32, scr, lane, a.in[I_NM]); continue; }
            r -= IT_BG;
            { const int which = r / IT_SQ; r -= which * IT_SQ; const int kb = r / 32, nb = r % 32;
              if (which == 0) p0_transpose_item(a.in[I_WCO], D, W4, 2048, 0, nb * 32, kb * 64, nb * 32, scr, lane);
              else if (which == 1) p0_transpose_item(a.in[I_WAO], D, W4, 2048, 1024, nb * 32, kb * 64, nb * 32, scr, lane);
              else p0_transpose_item(a.in[I_WOUT], D, W5, D, 0, nb * 32, kb * 64, nb * 32, scr, lane); }
        }
        const float* x = a.in[I_X]; const float* g1 = a.in[I_N1];
        f32x4 gv[4];
#pragma unroll
        for (int j = 0; j < 4; ++j) gv[j] = ((const f32x4*)g1)[64 * j + lane];
        for (int m0 = gw * 4; m0 < M; m0 += NGW * 4) {
            f32x4 v[4][4]; float sq[4];
#pragma unroll
            for (int r = 0; r < 4; ++r) { const f32x4* xr = (const f32x4*)(x + (size_t)(m0 + r) * D) + lane;
#pragma unroll
                for (int j = 0; j < 4; ++j) v[r][j] = xr[64 * j]; }
#pragma unroll
            for (int r = 0; r < 4; ++r) { float s = 0.f;
#pragma unroll
                for (int j = 0; j < 4; ++j) s += (v[r][j].x * v[r][j].x + v[r][j].y * v[r][j].y) + (v[r][j].z * v[r][j].z + v[r][j].w * v[r][j].w);
                sq[r] = s; }
#pragma unroll
            for (int o = 1; o < 64; o <<= 1) {
#pragma unroll
                for (int r = 0; r < 4; ++r) sq[r] += __shfl_xor(sq[r], o); }
#pragma unroll
            for (int r = 0; r < 4; ++r) { const float rstd = rsqrtf(sq[r] * (1.f / D) + EPS);
                u32x2* o8 = (u32x2*)(XN + (size_t)(m0 + r) * D) + lane;
#pragma unroll
                for (int j = 0; j < 4; ++j) { u32x2 o; o.x = cvtpk(v[r][j].x * rstd * gv[j].x, v[r][j].y * rstd * gv[j].y); o.y = cvtpk(v[r][j].z * rstd * gv[j].z, v[r][j].w * rstd * gv[j].w); o8[64 * j] = o; } }
        }
        asm volatile("s_waitcnt vmcnt(0) lgkmcnt(0)" ::: "memory"); __syncthreads();
    }
    SEAM(0);
    if (IN(1)) { pg8::Gemm g{XN, W1, D, 2 * FF, D}; pg8::StaticOrder S; S.init(M, 2 * FF, G, bx); pg8::EpiSwiglu E{HB, nullptr}; pg8::gemm_phase(lds, g, S, E); }
    SEAM(1);
    LAS float* red = (LAS float*)(lds + LDS_RED); LAS float* rstdl = (LAS float*)(lds + LDS_RSTD);
    if (IN(2)) { pg8::Gemm g{HB, W2, FF, D, FF}; pg8::StaticOrder S; S.init(M, D, G, bx); pg8::EpiResid<0> E{a.in[I_X], nullptr, nullptr, XN, 0.5f, PART1, red}; pg8::gemm_phase(lds, g, S, E); }
    SEAM(2);
    if (IN(3)) { pg8::Gemm g{XN, W3, D, N3, D}; pg8::StaticOrder S; S.init(M, N3, G, bx); rstd_prepass(S, PART1, rstdl, tid); pg8::EpiProj E{P, rstdl, a.in[I_BBG]}; pg8::gemm_phase(lds, g, S, E); }
    SEAM(3);
    if (IN(4)) {
        conv_pass(P, a.in[I_CONVW], vcu * 512 + tid, G * 512);
        {
            att::KVRegs R; int unit = vcu;
            if (unit < 1024) att::kv_load(R, P, unit, tid);
            for (; unit < 1024; unit += G) {
                att::kv_write(R, lds, a.in[I_KN], tid);
                __syncthreads();
                if (unit + G < 1024) att::kv_load(R, P, unit + G, tid);
                att::attn_compute(lds, P, a.in[I_QN], a.in[I_SINK], unit, wave, lane);
                __syncthreads();
            }
        }
        asm volatile("s_waitcnt vmcnt(0) lgkmcnt(0)" ::: "memory"); __syncthreads();
    }
    SEAM(4);
    bf16_t* MG = (bf16_t*)a.out;
    if (IN(5)) { pg8::Gemm g{P + PC_B, W4, NP, D, 2048}; pg8::StaticOrder S; S.init(M, D, G, bx); pg8::EpiMix E{P, MG}; pg8::gemm_phase(lds, g, S, E); }
    SEAM(5);
    if (IN(6)) { pg8::Gemm g{MG, W5, D, D, D}; pg8::StaticOrder S; S.init(M, D, G, bx); pg8::EpiResid<1> E{nullptr, XN, nullptr, X2G, 1.0f, PART2, red}; pg8::gemm_phase(lds, g, S, E); }
    SEAM(6);
    if (IN(7)) { pg8::Gemm g{X2G, W6, D, 2 * FF, D}; pg8::StaticOrder S; S.init(M, 2 * FF, G, bx); rstd_prepass(S, PART2, rstdl, tid); pg8::EpiSwiglu E{HB, rstdl}; pg8::gemm_phase(lds, g, S, E); }
    SEAM(7);
    if (IN(8)) { pg8::Gemm g{HB, W7, FF, D, FF}; pg8::StaticOrder S; S.init(M, D, G, bx); pg8::EpiResid<2> E{nullptr, X2G, a.out, nullptr, 0.5f, nullptr, red}; pg8::gemm_phase(lds, g, S, E); }
#undef IN
#undef SEAM
}

extern "C" void kernel_launch(void* const* d_in, const int* in_sizes, int n_in, void* d_out, int out_size, void* d_ws, size_t ws_size, hipStream_t stream) {
    static int grid = 0;
    if (grid == 0) {
        if (n_in != 20 || in_sizes[0] != M * D || out_size != M * D || ws_size < WS_END) { fprintf(stderr, "kernel_launch: unexpected shapes (n_in %d, in0 %d, out %d, ws %zu < %zu)\n", n_in, n_in > 0 ? in_sizes[0] : -1, out_size, ws_size, (size_t)WS_END); grid = -1; return; }
        int dev = 0, cus = 0, per_cu = 0;
        hipGetDevice(&dev); hipDeviceGetAttribute(&cus, hipDeviceAttributeMultiprocessorCount, dev);
        if (hipFuncSetAttribute((const void*)fwd, hipFuncAttributeMaxDynamicSharedMemorySize, LDS_BYTES) != hipSuccess) { fprintf(stderr, "kernel_launch: hipFuncSetAttribute failed\n"); grid = -1; return; }
        hipOccupancyMaxActiveBlocksPerMultiprocessor(&per_cu, (const void*)fwd, 512, LDS_BYTES);
        (void)hipGetLastError();
        if (per_cu < 1) per_cu = 1;
        grid = cus * 1;
        fprintf(stderr, "kernel_launch: cus %d per_cu %d grid %d\n", cus, per_cu, grid);
    }
    if (grid < 0) return;
    Args a{};
    for (int i = 0; i < 20; ++i) a.in[i] = (const float*)d_in[i];
    a.out = (float*)d_out; a.ws = (unsigned char*)d_ws;
#if MK_N_LAUNCHES == 1
    (void)hipMemsetAsync((char*)d_ws + WS_BAR, 0, XCD_BAR_WORDS * 4, stream);
    a.ph_lo = 0; a.ph_hi = 9;
    void* args[] = {&a};
    hipError_t e = hipLaunchCooperativeKernel((const void*)fwd, dim3(grid), dim3(512), args, LDS_BYTES, stream);
    if (e != hipSuccess) fprintf(stderr, "cooperative launch failed: %s (grid %d)\n", hipGetErrorString(e), grid);
#else
    for (int p = 0; p < 9; ++p) { a.ph_lo = p; a.ph_hi = p + 1; hipLaunchKernelGGL(fwd, dim3(grid), dim3(512), LDS_BYTES, stream, a); }
#endif
}
```

```cpp
#include <hip/hip_runtime.h>
#include <hip/hip_cooperative_groups.h>
#include <cstdio>
#include <cstdint>
namespace cg = cooperative_groups;

#ifndef MK_N_LAUNCHES
#define MK_N_LAUNCHES 1
#endif

#define LAS __attribute__((address_space(3)))
typedef unsigned short bf16_t;
typedef short bf16x8 __attribute__((ext_vector_type(8)));
typedef float f32x4 __attribute__((ext_vector_type(4)));
typedef float f32x16 __attribute__((ext_vector_type(16)));
typedef unsigned u32x4 __attribute__((ext_vector_type(4)));
typedef unsigned u32x2 __attribute__((ext_vector_type(2)));
typedef float f32x2_t __attribute__((ext_vector_type(2)));
typedef __bf16 bf16x2_t __attribute__((ext_vector_type(2)));

constexpr int M = 65536, D = 1024, FF = 2816, SEQ = 2048;
constexpr int NP = 5376;
constexpr int N3 = 6400;
constexpr int PC_Z = 0, PC_B = 1024, PC_Q = 2048, PC_K = 3072, PC_V = 3200, PC_GC = 3328, PC_GA = 4352;
constexpr float EPS = 1e-6f;
constexpr float LOG2E = 1.4426950408889634f;

constexpr size_t MiB = 1u << 20;
constexpr size_t WS_W1 = 0;
constexpr size_t WS_W2 = 11 * MiB;
constexpr size_t WS_W3 = 17 * MiB;
constexpr size_t WS_W4 = 30 * MiB;
constexpr size_t WS_W5 = 34 * MiB;
constexpr size_t WS_W6 = 36 * MiB;
constexpr size_t WS_W7 = 47 * MiB;
constexpr size_t WS_PART1 = 53 * MiB;
constexpr size_t WS_PART2 = 57 * MiB;
constexpr size_t WS_BAR = 61 * MiB;
constexpr size_t WS_XN = 64 * MiB;
constexpr size_t WS_P = 192 * MiB;
constexpr size_t WS_X2G = WS_P;
constexpr size_t WS_H = WS_P + 128 * MiB;
constexpr size_t WS_END = WS_P + 672 * MiB;

constexpr int RING_BYTES = 131072;
constexpr int LDS_BYTES = 163840;
constexpr int LDS_RED = RING_BYTES, LDS_BST = RING_BYTES + 4096, LDS_RSTD = RING_BYTES + 4160;

__device__ __forceinline__ unsigned cvtpk(float lo, float hi) { f32x2_t v = {lo, hi}; bf16x2_t b = __builtin_convertvector(v, bf16x2_t); return __builtin_bit_cast(unsigned, b); }
__device__ __forceinline__ float bflo(unsigned w) { return __uint_as_float(w << 16); }
__device__ __forceinline__ float bfhi(unsigned w) { return __uint_as_float(w & 0xffff0000u); }
__device__ __forceinline__ float sigmoidf_(float z) { return __builtin_amdgcn_rcpf(1.f + __expf(-z)); }
__device__ __forceinline__ float rstd_from_parts(const float* p) {
    const f32x4 a = *(const f32x4*)p;
    return rsqrtf(((a.x + a.y) + (a.z + a.w)) * (1.0f / 1024.0f) + EPS);
}

namespace pg8 {
constexpr int BM = 256, BK = 64, HALF = 128, HTB = HALF * BK * 2, STAGE_BYTES = 8 * HTB, NXCD = 8, WGM = 8;
__host__ __device__ __forceinline__ int lds_byte(int r, int c) { const int st = (r >> 4) * 2 + (c >> 5), rr = r & 15, cc = c & 31, ob = rr * 64 + cc * 2; return st * 1024 + (ob ^ (((ob >> 9) & 1) << 5)); }
__host__ __device__ __forceinline__ void stage_rc(int b, int& R, int& C) { const int st = b / 1024, sb = b % 1024, swz = sb ^ (((sb >> 9) & 1) << 5); R = (st >> 1) * 16 + swz / 64; C = (st & 1) * 32 + (swz % 64) / 2; }
__host__ __device__ __forceinline__ int perm32(int rho) { const int n = rho >> 4, i = rho & 15; return 8 * (i >> 2) + 4 * n + (i & 3); }

struct Unit { int pm, pn; };
struct Gemm { const bf16_t* A; const bf16_t* Bt; int lda, N, K; };

struct StaticOrder {
    int nM, nN, nwg, G, c;
    __device__ void init(int Mr, int N, int G_, int c_) { nM = Mr / BM; nN = N / BM; nwg = nM * nN; G = G_; c = c_; }
    __device__ bool next(int i, Unit& u) const {
        const long L = (long)i * G + c; if (L >= nwg) return false;
        int wgid = (int)L; { const int q = nwg / NXCD, r = nwg % NXCD, xcd = wgid % NXCD, off = wgid / NXCD; wgid = (xcd < r ? xcd * (q + 1) : r * (q + 1) + (xcd - r) * q) + off; }
        const int nig = WGM * nN, gid = wgid / nig, fm = gid * WGM, gsz = (nM - fm) < WGM ? (nM - fm) : WGM;
        u.pm = fm + ((wgid % nig) % gsz); u.pn = (wgid % nig) / gsz; return true;
    }
};

typedef f32x4 Acc[2][2][4][2];

struct EpiSwiglu {
    static constexpr bool HAS_MID = false; static constexpr int MID_T = -1;
    bf16_t* H; const LAS float* rtab;
    __device__ __forceinline__ void mid(Acc&, const Unit&, int, int, int, int) const {}
    __device__ __forceinline__ void operator()(const Acc& acc, const Unit& u, int wr, int wc, int fr, int fq, int ui) const {
        const int row0 = u.pm * BM + wr * 64 + fr, col0 = u.pn * HALF + wc * 32 + 8 * fq;
#pragma unroll
        for (int ai = 0; ai < 2; ++ai)
#pragma unroll
            for (int m = 0; m < 4; ++m) {
                const int row = row0 + ai * HALF + m * 16;
                const float rs = rtab ? rtab[ui * 256 + ai * HALF + wr * 64 + m * 16 + fr] : 1.0f;
                float h[8];
#pragma unroll
                for (int n = 0; n < 2; ++n)
#pragma unroll
                    for (int i = 0; i < 4; i += 2) {
                        const float g0 = acc[ai][0][m][n][i] * rs, g1 = acc[ai][0][m][n][i + 1] * rs, u0 = acc[ai][1][m][n][i] * rs, u1 = acc[ai][1][m][n][i + 1] * rs;
                        const float d0 = 1.f + __expf(fminf(-g0, 40.f)), d1 = 1.f + __expf(fminf(-g1, 40.f));
                        const float r = __builtin_amdgcn_rcpf(d0 * d1);
                        h[4 * n + i] = g0 * u0 * (d1 * r); h[4 * n + i + 1] = g1 * u1 * (d0 * r); }
                u32x4 w; w.x = cvtpk(h[0], h[1]); w.y = cvtpk(h[2], h[3]); w.z = cvtpk(h[4], h[5]); w.w = cvtpk(h[6], h[7]);
                *(u32x4*)(H + (size_t)row * FF + col0) = w;
            }
    }
};

template <int MODE> struct EpiResid {
    static constexpr bool HAS_MID = false; static constexpr int MID_T = -1;
    const float* basef; const bf16_t* baseb; float* outf; bf16_t* outb; float alpha; float* part; LAS float* red;
    __device__ __forceinline__ void mid(Acc&, const Unit&, int, int, int, int) const {}
    __device__ __forceinline__ void operator()(const Acc& acc, const Unit& u, int wr, int wc, int fr, int fq, int ui) const {
        const int row0 = u.pm * BM + wr * 64 + fr, col0 = u.pn * BM + wc * 32 + 8 * fq;
#pragma unroll
        for (int ai = 0; ai < 2; ++ai)
#pragma unroll
            for (int m = 0; m < 4; ++m) {
                const int row = row0 + ai * HALF + m * 16; float ss = 0.f;
#pragma unroll
                for (int bj = 0; bj < 2; ++bj) {
                    const size_t off = (size_t)row * D + col0 + bj * HALF;
                    f32x4 b0, b1;
                    if (MODE == 0) { b0 = *(const f32x4*)(basef + off); b1 = *(const f32x4*)(basef + off + 4); }
                    else { const u32x4 w = *(const u32x4*)(baseb + off); b0 = (f32x4){bflo(w.x), bfhi(w.x), bflo(w.y), bfhi(w.y)}; b1 = (f32x4){bflo(w.z), bfhi(w.z), bflo(w.w), bfhi(w.w)}; }
                    const f32x4 v0 = b0 + acc[ai][bj][m][0] * alpha, v1 = b1 + acc[ai][bj][m][1] * alpha;
                    if (MODE == 2) { *(f32x4*)(outf + off) = v0; *(f32x4*)(outf + off + 4) = v1; }
                    else {
                        ss += (v0.x * v0.x + v0.y * v0.y) + (v0.z * v0.z + v0.w * v0.w) + (v1.x * v1.x + v1.y * v1.y) + (v1.z * v1.z + v1.w * v1.w);
                        u32x4 w; w.x = cvtpk(v0.x, v0.y); w.y = cvtpk(v0.z, v0.w); w.z = cvtpk(v1.x, v1.y); w.w = cvtpk(v1.z, v1.w); *(u32x4*)(outb + off) = w;
                    }
                }
                if (MODE != 2) { ss += __shfl_xor(ss, 16); ss += __shfl_xor(ss, 32); if (fq == 0) red[(ai * HALF + wr * 64 + m * 16 + fr) * 4 + wc] = ss; }
            }
        if (MODE != 2) {
            asm volatile("s_waitcnt lgkmcnt(0)" ::: "memory"); __builtin_amdgcn_s_barrier(); asm volatile("" ::: "memory");
            const int t = threadIdx.x;
            if (t < 256) { const f32x4 r = *(const LAS f32x4*)(red + t * 4); part[(size_t)(u.pm * BM + t) * 4 + u.pn] = (r.x + r.y) + (r.z + r.w); }
            asm volatile("s_waitcnt lgkmcnt(0)" ::: "memory"); __builtin_amdgcn_s_barrier(); asm volatile("" ::: "memory");
        }
    }
};

struct EpiProj {
    static constexpr bool HAS_MID = false; static constexpr int MID_T = -1;
    bf16_t* P; const LAS float* rtab; const float* bias;
    __device__ __forceinline__ void mid(Acc&, const Unit&, int, int, int, int) const {}
    __device__ __forceinline__ void operator()(const Acc& acc, const Unit& u, int wr, int wc, int fr, int fq, int ui) const {
        const int row0 = u.pm * BM + wr * 64 + fr;
        if (u.pn < 8) {
            const int col0 = PC_Z + u.pn * HALF + wc * 32 + 8 * fq;
#pragma unroll
            for (int ai = 0; ai < 2; ++ai)
#pragma unroll
                for (int m = 0; m < 4; ++m) {
                    const int row = row0 + ai * HALF + m * 16; const float rs = rtab[ui * 256 + ai * HALF + wr * 64 + m * 16 + fr]; const float rs2 = rs * rs;
                    const f32x4 v0 = acc[ai][0][m][0] * acc[ai][1][m][0] * rs2, v1 = acc[ai][0][m][1] * acc[ai][1][m][1] * rs2;
                    u32x4 w; w.x = cvtpk(v0.x, v0.y); w.y = cvtpk(v0.z, v0.w); w.z = cvtpk(v1.x, v1.y); w.w = cvtpk(v1.z, v1.w);
                    *(u32x4*)(P + (size_t)row * NP + col0) = w;
                }
            return;
        }
        const int col0 = u.pn * BM - 1024 + wc * 32 + 8 * fq; const bool gate = u.pn >= 17;
        f32x4 bv[2][2];
#pragma unroll
        for (int bj = 0; bj < 2; ++bj)
#pragma unroll
            for (int n = 0; n < 2; ++n) bv[bj][n] = gate ? *(const f32x4*)(bias + (col0 - PC_GC) + bj * HALF + 4 * n) : (f32x4){0.f, 0.f, 0.f, 0.f};
#pragma unroll
        for (int ai = 0; ai < 2; ++ai)
#pragma unroll
            for (int m = 0; m < 4; ++m) {
                const int row = row0 + ai * HALF + m * 16; const float rs = rtab[ui * 256 + ai * HALF + wr * 64 + m * 16 + fr];
#pragma unroll
                for (int bj = 0; bj < 2; ++bj) {
                    f32x4 v0 = acc[ai][bj][m][0] * rs + bv[bj][0], v1 = acc[ai][bj][m][1] * rs + bv[bj][1];
                    if (gate) { v0.x = sigmoidf_(v0.x); v0.y = sigmoidf_(v0.y); v0.z = sigmoidf_(v0.z); v0.w = sigmoidf_(v0.w); v1.x = sigmoidf_(v1.x); v1.y = sigmoidf_(v1.y); v1.z = sigmoidf_(v1.z); v1.w = sigmoidf_(v1.w); }
                    u32x4 w; w.x = cvtpk(v0.x, v0.y); w.y = cvtpk(v0.z, v0.w); w.z = cvtpk(v1.x, v1.y); w.w = cvtpk(v1.z, v1.w);
                    *(u32x4*)(P + (size_t)row * NP + col0 + bj * HALF) = w;
                }
            }
    }
};

struct EpiMix {
    static constexpr bool HAS_MID = true; static constexpr int MID_T = 16;
    const bf16_t* P; bf16_t* out;
    __device__ __forceinline__ void mid(Acc& acc, const Unit& u, int wr, int wc, int fr, int fq) const {
        int row0 = u.pm * BM + wr * 64 + fr; const int col0 = u.pn * BM + wc * 32 + 8 * fq;
        asm volatile("" : "+v"(row0));
#pragma unroll
        for (int ai = 0; ai < 2; ++ai)
#pragma unroll
            for (int m = 0; m < 4; ++m) {
                const int row = row0 + ai * HALF + m * 16;
#pragma unroll
                for (int bj = 0; bj < 2; ++bj) {
                    const bf16_t* pr = P + (size_t)row * NP + col0 + bj * HALF;
                    const u32x4 gc = *(const u32x4*)(pr + PC_GC), ga = *(const u32x4*)(pr + PC_GA);
                    f32x4 r0, r1;
                    r0.x = bflo(gc.x) * __builtin_amdgcn_rcpf(fmaxf(bflo(ga.x), 1e-30f)); r0.y = bfhi(gc.x) * __builtin_amdgcn_rcpf(fmaxf(bfhi(ga.x), 1e-30f));
                    r0.z = bflo(gc.y) * __builtin_amdgcn_rcpf(fmaxf(bflo(ga.y), 1e-30f)); r0.w = bfhi(gc.y) * __builtin_amdgcn_rcpf(fmaxf(bfhi(ga.y), 1e-30f));
                    r1.x = bflo(gc.z) * __builtin_amdgcn_rcpf(fmaxf(bflo(ga.z), 1e-30f)); r1.y = bfhi(gc.z) * __builtin_amdgcn_rcpf(fmaxf(bfhi(ga.z), 1e-30f));
                    r1.z = bflo(gc.w) * __builtin_amdgcn_rcpf(fmaxf(bflo(ga.w), 1e-30f)); r1.w = bfhi(gc.w) * __builtin_amdgcn_rcpf(fmaxf(bfhi(ga.w), 1e-30f));
                    acc[ai][bj][m][0] *= r0; acc[ai][bj][m][1] *= r1;
                }
                if (m == 3) asm volatile("" ::: "memory");
            }
    }
    __device__ __forceinline__ void operator()(const Acc& acc, const Unit& u, int wr, int wc, int fr, int fq, int ui) const {
        const int row0 = u.pm * BM + wr * 64 + fr, col0 = u.pn * BM + wc * 32 + 8 * fq;
#pragma unroll
        for (int ai = 0; ai < 2; ++ai)
#pragma unroll
            for (int m = 0; m < 4; ++m) {
                const int row = row0 + ai * HALF + m * 16;
#pragma unroll
                for (int bj = 0; bj < 2; ++bj) {
                    const u32x4 ga = *(const u32x4*)(P + (size_t)row * NP + col0 + bj * HALF + PC_GA);
                    f32x4 g0, g1;
                    g0.x = fmaxf(bflo(ga.x), 1e-30f); g0.y = fmaxf(bfhi(ga.x), 1e-30f); g0.z = fmaxf(bflo(ga.y), 1e-30f); g0.w = fmaxf(bfhi(ga.y), 1e-30f);
                    g1.x = fmaxf(bflo(ga.z), 1e-30f); g1.y = fmaxf(bfhi(ga.z), 1e-30f); g1.z = fmaxf(bflo(ga.w), 1e-30f); g1.w = fmaxf(bfhi(ga.w), 1e-30f);
                    const f32x4 v0 = acc[ai][bj][m][0] * g0, v1 = acc[ai][bj][m][1] * g1;
                    u32x4 w; w.x = cvtpk(v0.x, v0.y); w.y = cvtpk(v0.z, v0.w); w.z = cvtpk(v1.x, v1.y); w.w = cvtpk(v1.z, v1.w);
                    *(u32x4*)(out + (size_t)row * D + col0 + bj * HALF) = w;
                }
            }
    }
};

template <class Epi>
__device__ __forceinline__ void gemm_phase(LAS unsigned char* lds, const Gemm g, const StaticOrder& S, const Epi& E) {
    const int tid = threadIdx.x, wid = __builtin_amdgcn_readfirstlane(tid >> 6), lane = tid & 63, wr = wid >> 2, wc = wid & 3, fr = lane & 15, fq = lane >> 4;
    const int K = g.K, nt = K / BK, lda = g.lda;
    unsigned voffA[2], voffB[2];
#pragma unroll
    for (int i = 0; i < 2; ++i) { int R, C; stage_rc(tid * 16 + i * 8192, R, C); const int Rb = (R & ~31) + perm32(R & 31);
        voffA[i] = (unsigned)(R * lda + C) * 2u; voffB[i] = (unsigned)(Rb * K + C) * 2u; }
    const size_t kstep = (size_t)(BK * 2);
    const size_t hstepA = (size_t)HALF * lda * 2, hstepB = (size_t)HALF * K * 2;
    const size_t tstepA = 2 * hstepA, tstepB = 2 * hstepB;
    const unsigned ldsw = (unsigned)wid * 1024u;
    const int aoff = lds_byte(wr * 64 + fr, fq * 8), boff = lds_byte(wc * 32 + fr, fq * 8);
#define PG8_SA(b, h) (((b) * 2 + (h)) * HTB)
#define PG8_SB(b, h) ((4 + (b) * 2 + (h)) * HTB)
#define PG8_STAGE(bufoff, gbase, voff) do { _Pragma("unroll") for (int _i = 0; _i < 2; ++_i) \
        __builtin_amdgcn_global_load_lds((const unsigned*)((const char*)(gbase) + (voff)[_i]), (LAS unsigned*)(lds + (bufoff) + ldsw + _i * 8192), 16, 0, 0); } while (0)
#define PG8_LDA(dst, b, h) do { _Pragma("unroll") for (int m = 0; m < 4; ++m) _Pragma("unroll") for (int k = 0; k < 2; ++k) dst[m][k] = *(const LAS bf16x8*)(lds + PG8_SA(b, h) + aoff + m * 2048 + k * 1024); } while (0)
#define PG8_LDB(dst, b, h) do { _Pragma("unroll") for (int n = 0; n < 2; ++n) _Pragma("unroll") for (int k = 0; k < 2; ++k) dst[n][k] = *(const LAS bf16x8*)(lds + PG8_SB(b, h) + boff + n * 2048 + k * 1024); } while (0)
#define PG8_MMA(ai, bj, At, Bt) do { __builtin_amdgcn_s_setprio(1); _Pragma("unroll") for (int m = 0; m < 4; ++m) _Pragma("unroll") for (int n = 0; n < 2; ++n) _Pragma("unroll") for (int k = 0; k < 2; ++k) \
        acc[ai][bj][m][n] = __builtin_amdgcn_mfma_f32_16x16x32_bf16(Bt[n][k], At[m][k], acc[ai][bj][m][n], 0, 0, 0); __builtin_amdgcn_s_setprio(0); } while (0)
#define PG8_WAIT_V(n) asm volatile("s_waitcnt vmcnt(" #n ")" ::: "memory")
#define PG8_WAIT_L(n) asm volatile("s_waitcnt lgkmcnt(" #n ")" ::: "memory")
#define PG8_BAR __builtin_amdgcn_s_barrier()
#define PG8_SCHED __builtin_amdgcn_sched_barrier(0)
    Unit cur, nxt; int ui = 0;
    if (!S.next(0, cur)) return;
    Acc acc;
#pragma unroll
    for (int a = 0; a < 2; ++a)
#pragma unroll
        for (int b = 0; b < 2; ++b)
#pragma unroll
            for (int m = 0; m < 4; ++m)
#pragma unroll
                for (int n = 0; n < 2; ++n) acc[a][b][m][n] = (f32x4){0.f, 0.f, 0.f, 0.f};
    bf16x8 At[4][2], B0[2][2], B1[2][2];
    const char* cA = (const char*)g.A + (size_t)cur.pm * tstepA; const char* cB = (const char*)g.Bt + (size_t)cur.pn * tstepB;
    PG8_STAGE(PG8_SB(0, 0), cB, voffB); PG8_STAGE(PG8_SB(0, 1), cB + hstepB, voffB); PG8_STAGE(PG8_SA(0, 0), cA, voffA); PG8_STAGE(PG8_SA(0, 1), cA + hstepA, voffA);
    if (wr == 1) PG8_BAR;
    PG8_WAIT_V(2); PG8_BAR;
    PG8_STAGE(PG8_SB(1, 0), cB + kstep, voffB); PG8_STAGE(PG8_SA(1, 0), cA + kstep, voffA); PG8_STAGE(PG8_SB(1, 1), cB + hstepB + kstep, voffB);
    PG8_WAIT_V(6); PG8_BAR;
    for (;;) {
        const bool has_next = S.next(ui + 1, nxt);
        const char* nA = has_next ? (const char*)g.A + (size_t)nxt.pm * tstepA : cA; const char* nB = has_next ? (const char*)g.Bt + (size_t)nxt.pn * tstepB : cB;
        for (int t = 0; t < nt; t += 2) {
            if constexpr (Epi::HAS_MID) { if (t == Epi::MID_T) { E.mid(acc, cur, wr, wc, fr, fq); PG8_SCHED; } }
            const bool last = (t == nt - 2);
            const char* a1 = cA + (size_t)(t + 1) * kstep;
            const char* a2 = last ? nA : cA + (size_t)(t + 2) * kstep; const char* b2 = last ? nB : cB + (size_t)(t + 2) * kstep;
            const char* a3 = a2 + kstep; const char* b3 = b2 + kstep;
            PG8_LDB(B0, 0, 0); PG8_LDB(B1, 0, 1); PG8_SCHED; PG8_LDA(At, 0, 0); PG8_STAGE(PG8_SA(1, 1), a1 + hstepA, voffA);
            PG8_WAIT_V(8); PG8_WAIT_L(0); PG8_BAR; PG8_MMA(0, 0, At, B0); PG8_MMA(0, 1, At, B1); PG8_BAR; PG8_SCHED;
            PG8_LDA(At, 0, 1); PG8_STAGE(PG8_SB(0, 0), b2, voffB); PG8_STAGE(PG8_SB(0, 1), b2 + hstepB, voffB); PG8_STAGE(PG8_SA(0, 0), a2, voffA);
            PG8_WAIT_V(8); PG8_WAIT_L(0); PG8_BAR; PG8_MMA(1, 0, At, B0); PG8_MMA(1, 1, At, B1); PG8_BAR; PG8_SCHED;
            PG8_LDB(B0, 1, 0); PG8_LDB(B1, 1, 1); PG8_SCHED; PG8_LDA(At, 1, 0); PG8_STAGE(PG8_SA(0, 1), a2 + hstepA, voffA);
            PG8_WAIT_V(8); PG8_WAIT_L(0); PG8_BAR; PG8_MMA(0, 0, At, B0); PG8_MMA(0, 1, At, B1); PG8_BAR; PG8_SCHED;
            PG8_LDA(At, 1, 1); PG8_STAGE(PG8_SB(1, 0), b3, voffB); PG8_STAGE(PG8_SB(1, 1), b3 + hstepB, voffB); PG8_STAGE(PG8_SA(1, 0), a3, voffA);
            PG8_WAIT_V(8); PG8_WAIT_L(0); PG8_BAR; PG8_MMA(1, 0, At, B0); PG8_MMA(1, 1, At, B1); PG8_BAR; PG8_SCHED;
        }
        if (wr == 0) PG8_BAR;
        E(acc, cur, wr, wc, fr, fq, ui);
        if (!has_next) break;
#pragma unroll
        for (int a = 0; a < 2; ++a)
#pragma unroll
            for (int b = 0; b < 2; ++b)
#pragma unroll
                for (int m = 0; m < 4; ++m)
#pragma unroll
                    for (int n = 0; n < 2; ++n) acc[a][b][m][n] = (f32x4){0.f, 0.f, 0.f, 0.f};
        cur = nxt; cA = nA; cB = nB; ++ui;
        if (wr == 1) PG8_BAR;
    }
    PG8_WAIT_V(0);
    PG8_BAR;
#undef PG8_SA
#undef PG8_SB
#undef PG8_STAGE
#undef PG8_LDA
#undef PG8_LDB
#undef PG8_MMA
#undef PG8_WAIT_V
#undef PG8_WAIT_L
#undef PG8_BAR
#undef PG8_SCHED
}
}

__device__ __forceinline__ float wave_sum(float v) {
#pragma unroll
    for (int o = 1; o < 64; o <<= 1) v += __shfl_xor(v, o);
    return v;
}
__device__ __forceinline__ void p0_transpose_item(const float* W, int N, bf16_t* WT, int ldk, int koff, int drow0, int k0, int n0, LAS float* scr, int lane, const float* ksc = nullptr) {
#pragma unroll 8
    for (int i = 0; i < 32; ++i) { const int kk = 2 * i + (lane >> 5); const float sc = ksc ? ksc[k0 + kk] : 1.0f; scr[kk * 33 + (lane & 31)] = W[(size_t)(k0 + kk) * N + n0 + (lane & 31)] * sc; }
    asm volatile("s_waitcnt lgkmcnt(0)" ::: "memory");
    const int c = lane & 7;
#pragma unroll
    for (int j = 0; j < 4; ++j) { const int n = (lane >> 3) + 8 * j; const LAS float* s = scr + (8 * c) * 33 + n;
        u32x4 o; o.x = cvtpk(s[0 * 33], s[1 * 33]); o.y = cvtpk(s[2 * 33], s[3 * 33]); o.z = cvtpk(s[4 * 33], s[5 * 33]); o.w = cvtpk(s[6 * 33], s[7 * 33]);
        *(u32x4*)(WT + (size_t)(drow0 + n) * ldk + koff + k0 + 8 * c) = o; }
    asm volatile("s_waitcnt lgkmcnt(0)" ::: "memory");
}

namespace att {
constexpr int KPB = 144;
constexpr int VP = 260;
constexpr int LDS_K = 0, LDS_V = 36864, LDS_WS = 70144, LDS_OST = 72192, LDS_NW = 104960, LDS_END = 105472;
__device__ __forceinline__ int crow(int r, int hi) { return (r & 3) + 8 * (r >> 2) + 4 * hi; }

struct KVRegs { u32x4 kr[4], vr[4]; };
__device__ __forceinline__ void kv_load(KVRegs& R, const bf16_t* P, int unit, int tid) {
    const int hk = unit & 1, n = (unit >> 1) & 15, b = unit >> 5;
    const int kk = tid >> 1, half = tid & 1; const int kp = n * 128 - 128 + kk;
    if (kp >= 0) { const bf16_t* pr = P + ((size_t)b * SEQ + kp) * NP + PC_K + hk * 64 + half * 32;
#pragma unroll
        for (int i = 0; i < 4; ++i) { R.kr[i] = *(const u32x4*)(pr + 8 * i); R.vr[i] = *(const u32x4*)(pr + 128 + 8 * i); } }
    else {
#pragma unroll
        for (int i = 0; i < 4; ++i) { R.kr[i] = (u32x4){0u, 0u, 0u, 0u}; R.vr[i] = (u32x4){0u, 0u, 0u, 0u}; } }
}
__device__ __forceinline__ void kv_write(const KVRegs& R, LAS unsigned char* lds, int tid) {
    const LAS float* kn_w = (const LAS float*)(lds + LDS_NW) + 64;
    const int kk = tid >> 1, half = tid & 1;
    float ss = 0.f;
#pragma unroll
    for (int i = 0; i < 4; ++i)
#pragma unroll
        for (int e = 0; e < 4; ++e) { const float a = bflo(R.kr[i][e]), c = bfhi(R.kr[i][e]); ss += a * a + c * c; }
    ss += __shfl_xor(ss, 1);
    const float rs = rsqrtf(ss * (1.0f / 64.0f) + EPS);
#pragma unroll
    for (int i = 0; i < 4; ++i) {
        const f32x4 w0 = *(const LAS f32x4*)(kn_w + half * 32 + 8 * i), w1 = *(const LAS f32x4*)(kn_w + half * 32 + 8 * i + 4);
        u32x4 o;
        o.x = cvtpk(bflo(R.kr[i].x) * rs * w0.x, bfhi(R.kr[i].x) * rs * w0.y); o.y = cvtpk(bflo(R.kr[i].y) * rs * w0.z, bfhi(R.kr[i].y) * rs * w0.w);
        o.z = cvtpk(bflo(R.kr[i].z) * rs * w1.x, bfhi(R.kr[i].z) * rs * w1.y); o.w = cvtpk(bflo(R.kr[i].w) * rs * w1.z, bfhi(R.kr[i].w) * rs * w1.w);
        *(LAS u32x4*)(lds + LDS_K + kk * KPB + half * 64 + 16 * i) = o;
    }
#pragma unroll
    for (int i = 0; i < 4; ++i)
#pragma unroll
        for (int e = 0; e < 8; ++e) {
            const unsigned short val = (unsigned short)((R.vr[i][e >> 1] >> (16 * (e & 1))) & 0xffffu);
            *(LAS unsigned short*)(lds + LDS_V + ((half * 32 + 8 * i + e) * VP + kk) * 2) = val;
        }
}
__device__ __forceinline__ void attn_compute(LAS unsigned char* lds, bf16_t* P, const float* sinks, int unit, int wid, int lane) {
    const LAS float* qn_w = (const LAS float*)(lds + LDS_NW);
    const int hk = unit & 1, n = (unit >> 1) & 15, b = unit >> 5;
    const int T0 = n * 128; const size_t rowbase = (size_t)b * SEQ;
    const int h = hk * 8 + wid, r32 = lane & 31, hi = lane >> 5;
    const float sink2 = sinks[h] * LOG2E;
    LAS float* wsf = (LAS float*)(lds + LDS_WS) + wid * 64;
    LAS bf16_t* stg = (LAS bf16_t*)(lds + LDS_OST) + wid * 2048;
    const float NEG = -1e30f;
    u32x4 qnext[4];
    { const bf16_t* qp = P + (rowbase + T0 + r32) * NP + PC_Q + h * 64;
#pragma unroll
      for (int d0 = 0; d0 < 4; ++d0) qnext[d0] = *(const u32x4*)(qp + 16 * d0 + 8 * hi); }
#pragma unroll 1
    for (int j = 0; j < 4; ++j) {
        u32x4 qraw[4]; float ss = 0.f;
#pragma unroll
        for (int d0 = 0; d0 < 4; ++d0) { qraw[d0] = qnext[d0];
#pragma unroll
            for (int e = 0; e < 4; ++e) { const float a = bflo(qraw[d0][e]), c = bfhi(qraw[d0][e]); ss += a * a + c * c; } }
        if (j < 3) { const bf16_t* qp = P + (rowbase + T0 + 32 * (j + 1) + r32) * NP + PC_Q + h * 64;
#pragma unroll
            for (int d0 = 0; d0 < 4; ++d0) qnext[d0] = *(const u32x4*)(qp + 16 * d0 + 8 * hi); }
        ss += __shfl_xor(ss, 32);
        const float rs = rsqrtf(ss * (1.0f / 64.0f) + EPS) * (0.125f * LOG2E);
        bf16x8 qr[4];
#pragma unroll
        for (int d0 = 0; d0 < 4; ++d0) {
            const f32x4 w0 = *(const LAS f32x4*)(qn_w + 16 * d0 + 8 * hi), w1 = *(const LAS f32x4*)(qn_w + 16 * d0 + 8 * hi + 4);
            u32x4 o;
            o.x = cvtpk(bflo(qraw[d0].x) * rs * w0.x, bfhi(qraw[d0].x) * rs * w0.y); o.y = cvtpk(bflo(qraw[d0].y) * rs * w0.z, bfhi(qraw[d0].y) * rs * w0.w);
            o.z = cvtpk(bflo(qraw[d0].z) * rs * w1.x, bfhi(qraw[d0].z) * rs * w1.y); o.w = cvtpk(bflo(qraw[d0].w) * rs * w1.z, bfhi(qraw[d0].w) * rs * w1.w);
            qr[d0] = __builtin_bit_cast(bf16x8, o);
        }
        f32x16 S[5];
#pragma unroll
        for (int c = 0; c < 5; ++c) {
            f32x16 p;
#pragma unroll
            for (int r = 0; r < 16; ++r) p[r] = 0.f;
#pragma unroll
            for (int d0 = 0; d0 < 4; ++d0) {
                const bf16x8 kf = *(const LAS bf16x8*)(lds + LDS_K + (32 * (j + c) + r32) * KPB + (16 * d0 + 8 * hi) * 2);
                p = __builtin_amdgcn_mfma_f32_32x32x16_bf16(kf, qr[d0], p, 0, 0, 0);
            }
            S[c] = p;
        }
#pragma unroll
        for (int r = 0; r < 16; ++r) { const int kl = crow(r, hi); if (!(kl > r32)) S[0][r] = NEG; if (!(kl <= r32)) S[4][r] = NEG; }
        if (n == 0) {
#pragma unroll
            for (int c = 0; c < 5; ++c) if (j + c < 4) {
#pragma unroll
                for (int r = 0; r < 16; ++r) S[c][r] = NEG; }
        }
        float mx = sink2;
#pragma unroll
        for (int c = 0; c < 5; ++c)
#pragma unroll
            for (int r = 0; r < 16; ++r) mx = fmaxf(mx, S[c][r]);
        mx = fmaxf(mx, __shfl_xor(mx, 32));
        float l = 0.f;
#pragma unroll
        for (int c = 0; c < 5; ++c)
#pragma unroll
            for (int r = 0; r < 16; ++r) { const float p = __builtin_amdgcn_exp2f(S[c][r] - mx); S[c][r] = p; l += p; }
        l += __shfl_xor(l, 32);
        l += __builtin_amdgcn_exp2f(sink2 - mx);
        f32x16 o0, o1;
#pragma unroll
        for (int r = 0; r < 16; ++r) { o0[r] = 0.f; o1[r] = 0.f; }
#pragma unroll
        for (int c = 0; c < 5; ++c)
#pragma unroll
            for (int s = 0; s < 2; ++s) {
                u32x4 pw; pw.x = cvtpk(S[c][8 * s + 0], S[c][8 * s + 1]); pw.y = cvtpk(S[c][8 * s + 2], S[c][8 * s + 3]); pw.z = cvtpk(S[c][8 * s + 4], S[c][8 * s + 5]); pw.w = cvtpk(S[c][8 * s + 6], S[c][8 * s + 7]);
                const bf16x8 pa = __builtin_bit_cast(bf16x8, pw);
                const int kv0 = 32 * (j + c) + 16 * s + 4 * hi;
                { const LAS unsigned char* va = lds + LDS_V + (r32 * VP + kv0) * 2;
                  const u32x2 lo = *(const LAS u32x2*)va, hh = *(const LAS u32x2*)(va + 16);
                  const u32x4 vb = {lo.x, lo.y, hh.x, hh.y};
                  o0 = __builtin_amdgcn_mfma_f32_32x32x16_bf16(pa, __builtin_bit_cast(bf16x8, vb), o0, 0, 0, 0); }
                { const LAS unsigned char* va = lds + LDS_V + ((32 + r32) * VP + kv0) * 2;
                  const u32x2 lo = *(const LAS u32x2*)va, hh = *(const LAS u32x2*)(va + 16);
                  const u32x4 vb = {lo.x, lo.y, hh.x, hh.y};
                  o1 = __builtin_amdgcn_mfma_f32_32x32x16_bf16(pa, __builtin_bit_cast(bf16x8, vb), o1, 0, 0, 0); }
            }
        if (hi == 0) wsf[r32] = __builtin_amdgcn_rcpf(l);
        asm volatile("s_waitcnt lgkmcnt(0)" ::: "memory");
#pragma unroll
        for (int r = 0; r < 16; ++r) { const int orow = crow(r, hi); const float rl = wsf[orow];
            stg[orow * 64 + r32] = (bf16_t)(cvtpk(o0[r] * rl, 0.f) & 0xffffu); stg[orow * 64 + 32 + r32] = (bf16_t)(cvtpk(o1[r] * rl, 0.f) & 0xffffu); }
        asm volatile("s_waitcnt lgkmcnt(0)" ::: "memory");
#pragma unroll
        for (int i = 0; i < 4; ++i) { const int row = i * 8 + (lane >> 3), ch = lane & 7; const u32x4 v = *(const LAS u32x4*)(stg + row * 64 + ch * 8);
            *(u32x4*)(P + (rowbase + T0 + 32 * j + row) * NP + PC_Q + h * 64 + ch * 8) = v; }
        asm volatile("s_waitcnt lgkmcnt(0)" ::: "memory");
    }
}
}

__device__ __forceinline__ void conv_pass(bf16_t* P, const float* cw, int gtid, int nthreads) {
    for (int it = gtid; it < (M / 16) * 128; it += nthreads) {
        const int c8 = (it & 127) * 8; const size_t r0 = (size_t)(it >> 7) * 16; const int t0 = (int)(r0 & (SEQ - 1));
        float w0[8], w1[8], w2[8], z1[8], z2[8];
        { const f32x4 a = *(const f32x4*)(cw + c8), b = *(const f32x4*)(cw + c8 + 4); w0[0] = a.x; w0[1] = a.y; w0[2] = a.z; w0[3] = a.w; w0[4] = b.x; w0[5] = b.y; w0[6] = b.z; w0[7] = b.w; }
        { const f32x4 a = *(const f32x4*)(cw + D + c8), b = *(const f32x4*)(cw + D + c8 + 4); w1[0] = a.x; w1[1] = a.y; w1[2] = a.z; w1[3] = a.w; w1[4] = b.x; w1[5] = b.y; w1[6] = b.z; w1[7] = b.w; }
        { const f32x4 a = *(const f32x4*)(cw + 2 * D + c8), b = *(const f32x4*)(cw + 2 * D + c8 + 4); w2[0] = a.x; w2[1] = a.y; w2[2] = a.z; w2[3] = a.w; w2[4] = b.x; w2[5] = b.y; w2[6] = b.z; w2[7] = b.w; }
        if (t0 == 0) {
#pragma unroll
            for (int e = 0; e < 8; ++e) { z1[e] = 0.f; z2[e] = 0.f; }
        } else {
            const u32x4 za = *(const u32x4*)(P + (r0 - 2) * NP + PC_Z + c8), zb = *(const u32x4*)(P + (r0 - 1) * NP + PC_Z + c8);
#pragma unroll
            for (int e = 0; e < 4; ++e) { z2[2 * e] = bflo(za[e]); z2[2 * e + 1] = bfhi(za[e]); z1[2 * e] = bflo(zb[e]); z1[2 * e + 1] = bfhi(zb[e]); }
        }
#pragma unroll 8
        for (int rr = 0; rr < 16; ++rr) {
            bf16_t* pr = P + (r0 + rr) * NP + c8;
            const u32x4 zz = *(const u32x4*)(pr + PC_Z), bb = *(const u32x4*)(pr + PC_B);
            float z0[8], y[8];
#pragma unroll
            for (int e = 0; e < 4; ++e) { z0[2 * e] = bflo(zz[e]); z0[2 * e + 1] = bfhi(zz[e]); }
#pragma unroll
            for (int e = 0; e < 8; ++e) y[e] = w0[e] * z2[e] + w1[e] * z1[e] + w2[e] * z0[e];
            u32x4 o;
#pragma unroll
            for (int e = 0; e < 4; ++e) o[e] = cvtpk(bflo(bb[e]) * y[2 * e], bfhi(bb[e]) * y[2 * e + 1]);
            *(u32x4*)(pr + PC_B) = o;
#pragma unroll
            for (int e = 0; e < 8; ++e) { z2[e] = z1[e]; z1[e] = z0[e]; }
        }
    }
}

#define XB_TMO      128
#define XB_XCNT(j)  (256  + 64 * (j))
#define XB_XSUB(j)  (1280 + 64 * (j))
#define XB_XGEN(j)  (2304 + 64 * (j))
#define XB_TOP      3328
#define XB_TOPGEN   3392
#define XCD_BAR_WORDS 3456
#define XB_SPIN_CAP (1u << 22)
__device__ __forceinline__ unsigned xb_ld(unsigned* p)              { return __hip_atomic_load(p, __ATOMIC_RELAXED, __HIP_MEMORY_SCOPE_AGENT); }
__device__ __forceinline__ unsigned xb_add(unsigned* p, unsigned v) { return __hip_atomic_fetch_add(p, v, __ATOMIC_RELAXED, __HIP_MEMORY_SCOPE_AGENT); }
__device__ __forceinline__ unsigned xb_xcc_id() { return (unsigned)__builtin_amdgcn_s_getreg((3 << 11) | 20) & 0xFu; }
#define XB_SPIN(cond, bar) do { unsigned _sp = 0; while (cond) { __builtin_amdgcn_s_sleep(1); \
    if ((++_sp & 255u) == 0u) { if (xb_ld(&(bar)[XB_TMO])) break; if (_sp > XB_SPIN_CAP) { atomicAdd(&(bar)[XB_TMO], 1u); break; } } } } while (0)
struct XcdBarrier { unsigned* bar; unsigned x; volatile LAS unsigned* st; };
__device__ __forceinline__ XcdBarrier xcd_barrier_post(unsigned* bar, volatile LAS unsigned* st) {
    XcdBarrier b; b.bar = bar; b.x = xb_xcc_id(); b.st = st;
    if (threadIdx.x == 0) (void)xb_add(&bar[XB_XCNT(b.x)], 1u);
    return b;
}
__device__ __forceinline__ void xcd_barrier_complete(unsigned* bar, unsigned x, unsigned& nloc, unsigned& nx) {
    const unsigned G = gridDim.x * gridDim.y * gridDim.z;
    unsigned sum, cnt, mine, sp = 0u;
    for (;;) {
        sum = 0u; cnt = 0u; mine = 0u;
#pragma unroll
        for (unsigned j = 0; j < 16; ++j) { const unsigned c = xb_ld(&bar[XB_XCNT(j)]); sum += c; cnt += (c > 0u) ? 1u : 0u; mine = (j == x) ? c : mine; }
        if (sum == G) break;
        __builtin_amdgcn_s_sleep(1);
        if ((++sp & 255u) == 0u) { if (xb_ld(&bar[XB_TMO])) break; if (sp > XB_SPIN_CAP) { atomicAdd(&bar[XB_TMO], 1u); break; } }
    }
    nloc = mine > 0u ? mine : 1u; nx = cnt > 0u ? cnt : 1u;
}
__device__ __forceinline__ void xcd_barrier(const XcdBarrier& b) {
    asm volatile("s_waitcnt vmcnt(0)" ::: "memory");
    __syncthreads();
    if (threadIdx.x == 0) {
        unsigned* bar = b.bar;
        __builtin_amdgcn_s_waitcnt(0);
        unsigned nloc = b.st[0], nx = b.st[1];
        if (nloc == 0u) { xcd_barrier_complete(bar, b.x, nloc, nx); b.st[0] = nloc; b.st[1] = nx; }
        const unsigned old = xb_add(&bar[XB_XSUB(b.x)], 1u);
        const unsigned gen = old / nloc;
        if (old + 1u == (gen + 1u) * nloc) {
            __builtin_amdgcn_fence(__ATOMIC_RELEASE, "agent");
            asm volatile("s_waitcnt vmcnt(0)" ::: "memory");
            const unsigned og = xb_add(&bar[XB_TOP], 1u);
            const unsigned tg = og / nx;
            if (og + 1u == (tg + 1u) * nx) xb_add(&bar[XB_TOPGEN], 1u);
            else XB_SPIN(xb_ld(&bar[XB_TOPGEN]) == tg, bar);
            __builtin_amdgcn_fence(__ATOMIC_ACQUIRE, "agent");
            xb_add(&bar[XB_XGEN(b.x)], 1u);
            asm volatile("s_waitcnt vmcnt(0)" ::: "memory");
        } else {
            XB_SPIN(xb_ld(&bar[XB_XGEN(b.x)]) == gen, bar);
            __builtin_amdgcn_fence(__ATOMIC_ACQUIRE, "agent");
            asm volatile("s_waitcnt vmcnt(0)" ::: "memory");
        }
    }
    __syncthreads();
}

__device__ __forceinline__ void rstd_prepass(const pg8::StaticOrder& S, const float* part, LAS float* tab, int tid) {
    if (tid < 256) {
        for (int i0 = 0; i0 < 32; i0 += 8) {
            f32x4 v[8]; bool ok[8];
#pragma unroll
            for (int j = 0; j < 8; ++j) { pg8::Unit u; ok[j] = S.next(i0 + j, u); v[j] = ok[j] ? *(const f32x4*)(part + (size_t)(u.pm * 256 + tid) * 4) : (f32x4){0.f, 0.f, 0.f, 0.f}; }
#pragma unroll
            for (int j = 0; j < 8; ++j) if (ok[j] && (i0 + j) < 25) tab[(i0 + j) * 256 + tid] = rsqrtf(((v[j].x + v[j].y) + (v[j].z + v[j].w)) * (1.0f / 1024.0f) + EPS);
        }
    }
    asm volatile("s_waitcnt vmcnt(0) lgkmcnt(0)" ::: "memory"); __syncthreads();
}

struct Args { const float* in[20]; float* out; unsigned char* ws; int ph_lo, ph_hi; };
enum { I_X = 0, I_N1, I_WG1, I_WU1, I_WD1, I_NM, I_WIN, I_CONVW, I_QN, I_KN, I_SINK, I_WCO, I_WAO, I_WBG, I_BBG, I_WOUT, I_N2, I_WG2, I_WU2, I_WD2 };

__global__ void __launch_bounds__(512, 2) fwd(Args a) {
    extern __shared__ __attribute__((aligned(16))) unsigned char lds_raw[];
    LAS unsigned char* lds = (LAS unsigned char*)lds_raw;
    const int tid = threadIdx.x, lane = tid & 63, wave = __builtin_amdgcn_readfirstlane(tid >> 6);
    const int G = gridDim.x, bx = blockIdx.x;
    const int vcu = (G % 8 == 0) ? (bx % 8) * (G / 8) + bx / 8 : bx;
    unsigned char* ws = a.ws;
    bf16_t* W1 = (bf16_t*)(ws + WS_W1); bf16_t* W2 = (bf16_t*)(ws + WS_W2); bf16_t* W3 = (bf16_t*)(ws + WS_W3); bf16_t* W4 = (bf16_t*)(ws + WS_W4);
    bf16_t* W5 = (bf16_t*)(ws + WS_W5); bf16_t* W6 = (bf16_t*)(ws + WS_W6); bf16_t* W7 = (bf16_t*)(ws + WS_W7);
    float* PART1 = (float*)(ws + WS_PART1); float* PART2 = (float*)(ws + WS_PART2);
    bf16_t* XN = (bf16_t*)(ws + WS_XN); bf16_t* P = (bf16_t*)(ws + WS_P); bf16_t* X2G = (bf16_t*)(ws + WS_X2G); bf16_t* HB = (bf16_t*)(ws + WS_H);
    const int lo = a.ph_lo, hi = a.ph_hi;
#ifndef PH_MASK
#define PH_MASK 0x1ff
#endif
#define IN(k) (((PH_MASK >> (k)) & 1) && lo <= (k) && (k) < hi)
    volatile LAS unsigned* bst = (volatile LAS unsigned*)(lds + LDS_BST);
    if (tid < 2) bst[tid] = 0u;
    __syncthreads();
#if MK_N_LAUNCHES == 1
    XcdBarrier xbar = xcd_barrier_post((unsigned*)(ws + WS_BAR), bst);
    if (a.ph_lo < 0) cg::this_grid().sync();
#define SEAM(k) do { if (IN(k) && IN((k) + 1)) xcd_barrier(xbar); } while (0)
#else
#define SEAM(k) do { } while (0)
#endif

    if (IN(0)) {
        LAS float* scr = (LAS float*)(lds + wave * 16384);
        const int gw = vcu * 8 + wave, NGW = G * 8;
        constexpr int NB_FF = FF / 32, IT_GU = 16 * NB_FF, IT_DN = (FF / 64) * 32, IT_IN = 16 * 136, IT_BG = 16 * 64, IT_SQ = 16 * 32;
        constexpr int NITEMS = 4 * IT_GU + 2 * IT_DN + IT_IN + IT_BG + 3 * IT_SQ;
        for (int it = gw; it < NITEMS; it += NGW) {
            int r = it;
            if (r < 4 * IT_GU) {
                const int which = r / IT_GU; r -= which * IT_GU; const int kb = r / NB_FF, nb = r % NB_FF, n0 = nb * 32;
                const float* W = a.in[which == 0 ? I_WG1 : which == 1 ? I_WU1 : which == 2 ? I_WG2 : I_WU2];
                p0_transpose_item(W, FF, (which < 2) ? W1 : W6, D, 0, 256 * (n0 >> 7) + 128 * (which & 1) + (n0 & 127), kb * 64, n0, scr, lane, (which < 2) ? nullptr : a.in[I_N2]); continue; }
            r -= 4 * IT_GU;
            if (r < 2 * IT_DN) { const int which = r / IT_DN; r -= which * IT_DN; const int kb = r / 32, nb = r % 32;
                p0_transpose_item(a.in[which ? I_WD2 : I_WD1], D, which ? W7 : W2, FF, 0, nb * 32, kb * 64, nb * 32, scr, lane); continue; }
            r -= 2 * IT_DN;
            if (r < IT_IN) { const int kb = r / 136, nb = r % 136, n0 = nb * 32;
                const int cz = (n0 - 1024) & 1023;
                const int dr = n0 < 1024 ? n0 + 2048 : (n0 < 2048 ? 256 * (cz >> 7) + (cz & 127) : (n0 < 3072 ? 256 * (cz >> 7) + 128 + (cz & 127) : n0));
                p0_transpose_item(a.in[I_WIN], 4352, W3, D, 0, dr, kb * 64, n0, scr, lane, a.in[I_NM]); continue; }
            r -= IT_IN;
            if (r < IT_BG) { const int kb = r / 64, nb = r % 64; p0_transpose_item(a.in[I_WBG], 2048, W3, D, 0, 4352 + nb * 32, kb * 64, nb * 32, scr, lane, a.in[I_NM]); continue; }
            r -= IT_BG;
            { const int which = r / IT_SQ; r -= which * IT_SQ; const int kb = r / 32, nb = r % 32;
              if (which == 0) p0_transpose_item(a.in[I_WCO], D, W4, 2048, 0, nb * 32, kb * 64, nb * 32, scr, lane);
              else if (which == 1) p0_transpose_item(a.in[I_WAO], D, W4, 2048, 1024, nb * 32, kb * 64, nb * 32, scr, lane);
              else p0_transpose_item(a.in[I_WOUT], D, W5, D, 0, nb * 32, kb * 64, nb * 32, scr, lane); }
        }
        const float* x = a.in[I_X]; const float* g1 = a.in[I_N1];
        f32x4 gv[4];
#pragma unroll
        for (int j = 0; j < 4; ++j) gv[j] = ((const f32x4*)g1)[64 * j + lane];
        for (int m0 = gw * 4; m0 < M; m0 += NGW * 4) {
            f32x4 v[4][4]; float sq[4];
#pragma unroll
            for (int r = 0; r < 4; ++r) { const f32x4* xr = (const f32x4*)(x + (size_t)(m0 + r) * D) + lane;
#pragma unroll
                for (int j = 0; j < 4; ++j) v[r][j] = xr[64 * j]; }
#pragma unroll
            for (int r = 0; r < 4; ++r) { float s = 0.f;
#pragma unroll
                for (int j = 0; j < 4; ++j) s += (v[r][j].x * v[r][j].x + v[r][j].y * v[r][j].y) + (v[r][j].z * v[r][j].z + v[r][j].w * v[r][j].w);
                sq[r] = s; }
#pragma unroll
            for (int o = 1; o < 64; o <<= 1) {
#pragma unroll
                for (int r = 0; r < 4; ++r) sq[r] += __shfl_xor(sq[r], o); }
#pragma unroll
            for (int r = 0; r < 4; ++r) { const float rstd = rsqrtf(sq[r] * (1.f / D) + EPS);
                u32x2* o8 = (u32x2*)(XN + (size_t)(m0 + r) * D) + lane;
#pragma unroll
                for (int j = 0; j < 4; ++j) { u32x2 o; o.x = cvtpk(v[r][j].x * rstd * gv[j].x, v[r][j].y * rstd * gv[j].y); o.y = cvtpk(v[r][j].z * rstd * gv[j].z, v[r][j].w * rstd * gv[j].w); o8[64 * j] = o; } }
        }
        asm volatile("s_waitcnt vmcnt(0) lgkmcnt(0)" ::: "memory"); __syncthreads();
    }
    SEAM(0);
    if (IN(1)) { pg8::Gemm g{XN, W1, D, 2 * FF, D}; pg8::StaticOrder S; S.init(M, 2 * FF, G, bx); pg8::EpiSwiglu E{HB, nullptr}; pg8::gemm_phase(lds, g, S, E); }
    SEAM(1);
    LAS float* red = (LAS float*)(lds + LDS_RED); LAS float* rstdl = (LAS float*)(lds + LDS_RSTD);
    if (IN(2)) { pg8::Gemm g{HB, W2, FF, D, FF}; pg8::StaticOrder S; S.init(M, D, G, bx); pg8::EpiResid<0> E{a.in[I_X], nullptr, nullptr, XN, 0.5f, PART1, red}; pg8::gemm_phase(lds, g, S, E); }
    SEAM(2);
    if (IN(3)) { pg8::Gemm g{XN, W3, D, N3, D}; pg8::StaticOrder S; S.init(M, N3, G, bx); rstd_prepass(S, PART1, rstdl, tid); pg8::EpiProj E{P, rstdl, a.in[I_BBG]}; pg8::gemm_phase(lds, g, S, E); }
    SEAM(3);
    if (IN(4)) {
        conv_pass(P, a.in[I_CONVW], vcu * 512 + tid, G * 512);
        {
            att::KVRegs R; int unit = vcu;
            if (unit < 1024) att::kv_load(R, P, unit, tid);
            if (tid < 128) ((LAS float*)(lds + att::LDS_NW))[tid] = tid < 64 ? a.in[I_QN][tid] : a.in[I_KN][tid - 64];
            __syncthreads();
            for (; unit < 1024; unit += G) {
                att::kv_write(R, lds, tid);
                __syncthreads();
                if (unit + G < 1024) att::kv_load(R, P, unit + G, tid);
                att::attn_compute(lds, P, a.in[I_SINK], unit, wave, lane);
                __syncthreads();
            }
        }
        asm volatile("s_waitcnt vmcnt(0) lgkmcnt(0)" ::: "memory"); __syncthreads();
    }
    SEAM(4);
    bf16_t* MG = (bf16_t*)a.out;
    if (IN(5)) { pg8::Gemm g{P + PC_B, W4, NP, D, 2048}; pg8::StaticOrder S; S.init(M, D, G, bx); pg8::EpiMix E{P, MG}; pg8::gemm_phase(lds, g, S, E); }
    SEAM(5);
    if (IN(6)) { pg8::Gemm g{MG, W5, D, D, D}; pg8::StaticOrder S; S.init(M, D, G, bx); pg8::EpiResid<1> E{nullptr, XN, nullptr, X2G, 1.0f, PART2, red}; pg8::gemm_phase(lds, g, S, E); }
    SEAM(6);
    if (IN(7)) { pg8::Gemm g{X2G, W6, D, 2 * FF, D}; pg8::StaticOrder S; S.init(M, 2 * FF, G, bx); rstd_prepass(S, PART2, rstdl, tid); pg8::EpiSwiglu E{HB, rstdl}; pg8::gemm_phase(lds, g, S, E); }
    SEAM(7);
    if (IN(8)) { pg8::Gemm g{HB, W7, FF, D, FF}; pg8::StaticOrder S; S.init(M, D, G, bx); pg8::EpiResid<2> E{nullptr, X2G, a.out, nullptr, 0.5f, nullptr, red}; pg8::gemm_phase(lds, g, S, E); }
#undef IN
#undef SEAM
}

extern "C" void kernel_launch(void* const* d_in, const int* in_sizes, int n_in, void* d_out, int out_size, void* d_ws, size_t ws_size, hipStream_t stream) {
    static int grid = 0;
    if (grid == 0) {
        if (n_in != 20 || in_sizes[0] != M * D || out_size != M * D || ws_size < WS_END) { fprintf(stderr, "kernel_launch: unexpected shapes (n_in %d, in0 %d, out %d, ws %zu < %zu)\n", n_in, n_in > 0 ? in_sizes[0] : -1, out_size, ws_size, (size_t)WS_END); grid = -1; return; }
        int dev = 0, cus = 0, per_cu = 0;
        hipGetDevice(&dev); hipDeviceGetAttribute(&cus, hipDeviceAttributeMultiprocessorCount, dev);
        if (hipFuncSetAttribute((const void*)fwd, hipFuncAttributeMaxDynamicSharedMemorySize, LDS_BYTES) != hipSuccess) { fprintf(stderr, "kernel_launch: hipFuncSetAttribute failed\n"); grid = -1; return; }
        hipOccupancyMaxActiveBlocksPerMultiprocessor(&per_cu, (const void*)fwd, 512, LDS_BYTES);
        (void)hipGetLastError();
        if (per_cu < 1) per_cu = 1;
        grid = cus * 1;
        fprintf(stderr, "kernel_launch: cus %d per_cu %d grid %d\n", cus, per_cu, grid);
    }
    if (grid < 0) return;
    Args a{};
    for (int i = 0; i < 20; ++i) a.in[i] = (const float*)d_in[i];
    a.out = (float*)d_out; a.ws = (unsigned char*)d_ws;
#if MK_N_LAUNCHES == 1
    (void)hipMemsetAsync((char*)d_ws + WS_BAR, 0, XCD_BAR_WORDS * 4, stream);
    a.ph_lo = 0; a.ph_hi = 9;
    void* args[] = {&a};
    hipError_t e = hipLaunchCooperativeKernel((const void*)fwd, dim3(grid), dim3(512), args, LDS_BYTES, stream);
    if (e != hipSuccess) fprintf(stderr, "cooperative launch failed: %s (grid %d)\n", hipGetErrorString(e), grid);
#else
    for (int p = 0; p < 9; ++p) { a.ph_lo = p; a.ph_hi = p + 1; hipLaunchKernelGGL(fwd, dim3(grid), dim3(512), LDS_BYTES, stream, a); }
#endif
}
```
